# Optimizing an MI355X kernel written in HIP

```python
import jax, jax.numpy as jnp
from jax import lax
import numpy as np

D_MODEL = 1024
BATCH = 32
SEQ = 2048
DEPTH = 4

GRID_W = 64
D_ATTN = D_MODEL // 2
HEAD_DIM = 64
N_HEADS = D_ATTN // HEAD_DIM
WIN_H_MAX = 8
WIN_W = 16
Q_COLS = 16
K_COLS = Q_COLS + WIN_W
NEG_INF = -1e30
D_POOL = D_MODEL - D_ATTN
POOL_WINDOWS = (2, 4, 8, 16)
N_POOL_GROUPS = len(POOL_WINDOWS)
POOL_GROUP_DIM = D_POOL // N_POOL_GROUPS
D_MIX = D_ATTN + D_POOL
D_IN = 3 * D_ATTN + D_POOL
N_GROUPS = 4
EXPERTS_PER_GROUP = 4
N_EXPERTS = N_GROUPS * EXPERTS_PER_GROUP
TOP_K_IN_GROUP = 2
D_EXPERT = 512
EPS = 1e-6

kernel_name = "hymba_natten_poolformer_hiermoe_encoder"


def rmsnorm(x, g):
    xf = x.astype(jnp.float32)
    y = xf * lax.rsqrt(jnp.mean(xf * xf, axis=-1, keepdims=True) + EPS)
    return (y * g.astype(jnp.float32)).astype(x.dtype)


def neighbourhood_attention(q, k, v, rpb):
    B, S, H, hd = q.shape
    rows = S // GRID_W
    kh = min(WIN_H_MAX, rows)
    n_cb = GRID_W // Q_COLS
    qc = np.arange(GRID_W).reshape(n_cb, Q_COLS)
    kc_start = np.clip(np.arange(n_cb) * Q_COLS - WIN_W // 2, 0, GRID_W - K_COLS)
    kc = kc_start[:, None] + np.arange(K_COLS)[None, :]
    qc_start = np.clip(qc - WIN_W // 2, 0, GRID_W - WIN_W)
    col_valid = (kc[:, None, :] >= qc_start[:, :, None]) & (kc[:, None, :] < qc_start[:, :, None] + WIN_W)
    dc = np.clip(kc[:, None, :] - qc[:, :, None], -(WIN_W - 1), WIN_W - 1) + WIN_W - 1
    r = np.arange(rows)
    r_start = np.clip(r - kh // 2, 0, rows - kh)
    kr = r_start[:, None] + np.arange(kh)[None, :]
    dr = kr - r[:, None] + WIN_H_MAX - 1
    bias = jnp.take(rpb[:, dr, :], dc, axis=-1)
    bias = bias.transpose(1, 0, 3, 4, 2, 5).astype(jnp.float32)
    valid = col_valid[:, :, None, :]

    scale = hd ** -0.5
    q_rows = (q * scale).reshape(B, rows, n_cb, Q_COLS, H, hd).transpose(1, 0, 4, 2, 3, 5)
    k_grid = k.reshape(B, rows, GRID_W, H, hd)
    v_grid = v.reshape(B, rows, GRID_W, H, hd)

    def row_block(args):
        rs, q_r, b_r = args
        k_r = jnp.take(lax.dynamic_slice_in_dim(k_grid, rs, kh, axis=1), kc, axis=2)
        v_r = jnp.take(lax.dynamic_slice_in_dim(v_grid, rs, kh, axis=1), kc, axis=2)
        s = jnp.einsum('bhnqd,binkhd->bhnqik', q_r, k_r).astype(jnp.float32) + b_r
        s = jnp.where(valid, s, NEG_INF)
        p = jax.nn.softmax(s.reshape(s.shape[:4] + (kh * K_COLS,)), axis=-1)
        p = p.reshape(s.shape).astype(v.dtype)
        return jnp.einsum('bhnqik,binkhd->bhnqd', p, v_r)

    out = lax.map(row_block, (jnp.asarray(r_start, jnp.int32), q_rows, bias))
    return out.transpose(1, 0, 3, 4, 2, 5).reshape(B, S, H * hd)


def pooling_mixer(u, pool_w, pool_scale):
    B, S, _ = u.shape
    uf = u.astype(jnp.float32)
    cs = jnp.concatenate([jnp.zeros((B, 1, D_POOL), jnp.float32), jnp.cumsum(uf, axis=1)], axis=1)
    t = np.arange(S)
    outs = []
    for g, w in enumerate(POOL_WINDOWS):
        lo = np.clip(t - w // 2, 0, S)
        hi = np.clip(t - w // 2 + w, 0, S)
        cnt = (hi - lo).astype(np.float32)[None, :, None]
        sl = slice(g * POOL_GROUP_DIM, (g + 1) * POOL_GROUP_DIM)
        outs.append((cs[:, hi, sl] - cs[:, lo, sl]) / cnt - uf[:, :, sl])
    pooled = jnp.stack(outs, axis=2).astype(u.dtype)
    mixed = jnp.einsum('bsgc,gcd->bsgd', pooled, pool_w).reshape(B, S, D_POOL)
    return mixed * pool_scale


def hierarchical_moe(h, w_rg, w_re, w_gate, w_up, w_down):
    B, S, D = h.shape
    T = B * S
    tok = h.reshape(T, D)
    g_logits = (tok @ w_rg).astype(jnp.float32)
    g_prob = jax.nn.softmax(g_logits, axis=-1)
    g_idx = jnp.argmax(g_logits, axis=-1)
    g_w = jnp.take_along_axis(g_prob, g_idx[:, None], axis=-1)
    e_logits = (tok @ w_re).astype(jnp.float32).reshape(T, N_GROUPS, EXPERTS_PER_GROUP)
    e_logits = jnp.take_along_axis(e_logits, g_idx[:, None, None], axis=1)[:, 0]
    top_v, top_i = lax.top_k(e_logits, TOP_K_IN_GROUP)
    top_w = jax.nn.softmax(top_v, axis=-1) * g_w
    expert_id = g_idx[:, None] * EXPERTS_PER_GROUP + top_i
    combine = jnp.sum(jax.nn.one_hot(expert_id, N_EXPERTS, dtype=jnp.float32) * top_w[..., None], axis=1)
    y = jnp.zeros((T, D), jnp.float32)
    for e in range(N_EXPERTS):
        a = jax.nn.silu(tok @ w_gate[e]) * (tok @ w_up[e])
        y = y + combine[:, e:e + 1] * (a @ w_down[e]).astype(jnp.float32)
    return y.astype(h.dtype).reshape(B, S, D)


def setup_inputs(seed: int = 0) -> dict:
    key = jax.random.key(seed)
    ks = jax.random.split(key, 16)
    f32 = jnp.float32
    res_scale = (2 * DEPTH) ** -0.5
    x = jax.random.normal(ks[0], (BATCH, SEQ, D_MODEL), f32)
    norm_mix_g = 1.0 + 0.05 * jax.random.normal(ks[1], (DEPTH, D_MODEL), f32)
    w_in = jax.random.normal(ks[2], (DEPTH, D_MODEL, D_IN), f32) * D_MODEL ** -0.5
    rpb = 0.2 * jax.random.normal(ks[3], (DEPTH, N_HEADS, 2 * WIN_H_MAX - 1, 2 * WIN_W - 1), f32)
    pool_w = jax.random.normal(ks[4], (DEPTH, N_POOL_GROUPS, POOL_GROUP_DIM, POOL_GROUP_DIM), f32) * POOL_GROUP_DIM ** -0.5
    pool_scale = 1.0 + 0.1 * jax.random.normal(ks[5], (DEPTH, D_POOL), f32)
    w_out = jax.random.normal(ks[6], (DEPTH, D_MIX, D_MODEL), f32) * (D_MIX ** -0.5) * res_scale
    norm_ffn_g = 1.0 + 0.05 * jax.random.normal(ks[7], (DEPTH, D_MODEL), f32)
    w_router_group = jax.random.normal(ks[8], (DEPTH, D_MODEL, N_GROUPS), f32) * D_MODEL ** -0.5
    w_router_expert = jax.random.normal(ks[9], (DEPTH, D_MODEL, N_EXPERTS), f32) * D_MODEL ** -0.5
    w_gate = jax.random.normal(ks[10], (DEPTH, N_EXPERTS, D_MODEL, D_EXPERT), f32) * D_MODEL ** -0.5
    w_up = jax.random.normal(ks[11], (DEPTH, N_EXPERTS, D_MODEL, D_EXPERT), f32) * D_MODEL ** -0.5
    w_down = jax.random.normal(ks[12], (DEPTH, N_EXPERTS, D_EXPERT, D_MODEL), f32) * (D_EXPERT ** -0.5) * res_scale
    final_g = 1.0 + 0.05 * jax.random.normal(ks[13], (D_MODEL,), f32)
    return {"x": x, "norm_mix_g": norm_mix_g, "w_in": w_in, "rpb": rpb, "pool_w": pool_w,
            "pool_scale": pool_scale, "w_out": w_out, "norm_ffn_g": norm_ffn_g,
            "w_router_group": w_router_group, "w_router_expert": w_router_expert,
            "w_gate": w_gate, "w_up": w_up, "w_down": w_down, "final_g": final_g}


def reference(x, norm_mix_g, w_in, rpb, pool_w, pool_scale, w_out, norm_ffn_g,
              w_router_group, w_router_expert, w_gate, w_up, w_down, final_g):
    B, S, _ = x.shape
    for l in range(DEPTH):
        h = rmsnorm(x, norm_mix_g[l])
        proj = h @ w_in[l]
        q = proj[..., :D_ATTN].reshape(B, S, N_HEADS, HEAD_DIM)
        k = proj[..., D_ATTN:2 * D_ATTN].reshape(B, S, N_HEADS, HEAD_DIM)
        v = proj[..., 2 * D_ATTN:3 * D_ATTN].reshape(B, S, N_HEADS, HEAD_DIM)
        u = proj[..., 3 * D_ATTN:]
        a = neighbourhood_attention(q, k, v, rpb[l])
        p = pooling_mixer(u, pool_w[l], pool_scale[l])
        x = x + jnp.concatenate([a, p], axis=-1) @ w_out[l]
        x = x + hierarchical_moe(rmsnorm(x, norm_ffn_g[l]), w_router_group[l], w_router_expert[l],
                                 w_gate[l], w_up[l], w_down[l])
    return rmsnorm(x, final_g)
```

```cpp
#include <hip/hip_runtime.h>
#include <cstdio>
#include <cstdint>

#define REP_P0 1
#define REP_P1 1
#define REP_P2 1
#define REP_P3L0 1
#define REP_P5 1
#ifndef MK_N_LAUNCHES
#define MK_N_LAUNCHES 1
#endif

#define GAS __attribute__((address_space(1)))
#define LAS __attribute__((address_space(3)))
typedef unsigned short bf16;
typedef short bf16x8 __attribute__((ext_vector_type(8)));
typedef short s16x4 __attribute__((ext_vector_type(4)));
typedef float f32x4 __attribute__((ext_vector_type(4)));
typedef float f32x2 __attribute__((ext_vector_type(2)));
typedef float f32x16 __attribute__((ext_vector_type(16)));
typedef unsigned u32x4 __attribute__((ext_vector_type(4)));
typedef unsigned u32x2 __attribute__((ext_vector_type(2)));
typedef GAS unsigned gu32;

constexpr int D = 1024, BATCH = 32, SEQ = 2048, T = BATCH * SEQ, DEPTH = 4;
constexpr int DIN = 2048, NH = 8, HD = 64, GRIDW = 64, ROWS = SEQ / GRIDW;
constexpr int NE = 16, DE = 512, NBUCKET = 24;
constexpr float EPS = 1e-6f, LOG2E = 1.4426950408889634f;
constexpr int NWAVES = 8, NTHREADS = 512;

constexpr size_t MiB = 1u << 20;
constexpr size_t WS_CTL = 0, CTL_ZERO_BYTES = 1 * MiB;
constexpr size_t WS_WIN = 2 * MiB;
constexpr size_t WS_WOUT = 18 * MiB;
constexpr size_t WS_WGU = 26 * MiB;
constexpr size_t WS_WD = 154 * MiB;
constexpr size_t WS_RFRAG = 218 * MiB;
constexpr size_t WS_SSQ = 219 * MiB;
constexpr size_t WS_LIST = 223 * MiB;
constexpr size_t WS_XB = 248 * MiB;
constexpr size_t WS_PROJ = 376 * MiB;
constexpr size_t WS_H = WS_PROJ;
constexpr size_t WS_MIX = 632 * MiB;
constexpr size_t WS_X8 = 760 * MiB;
constexpr size_t WS_WIN8 = 824 * MiB;
constexpr size_t WS_QKV8 = 832 * MiB;
constexpr size_t WS_END = 928 * MiB;
constexpr float SC_Q8 = 16.0f, SC_KV8 = 4.0f, SC_A8 = 16.0f;
constexpr int MIXP = 1536;
constexpr float SC_X8 = 4.0f, SC_WGU = 64.0f, SC_H8 = 16.0f, SC_WD = 128.0f;
constexpr int MAXTILES = T / 256 + NBUCKET;
static_assert((size_t)MAXTILES * 256 * 1024 * 2 <= 256 * MiB, "H fits the proj overlay");
constexpr int CW_TMO = 0, CW_CODE = 1, CW_BAR = 4096, CW_CNT = 8192;

constexpr int RING_BYTES = 131072;
constexpr int KRING_OFF = 0, VRING_OFF = 73728, ATT_RING_END = 147456;
constexpr int BIAS_OFF = ATT_RING_END;
constexpr int MISC_OFF = BIAS_OFF + 2048;
constexpr int LDS_BYTES = MISC_OFF + 512;
constexpr int MW_BAR = 0, MW_CNTL = 4, MW_BASEL = 32, MW_TB = 64, MW_CNT2 = 96;

#define RLX_AGENT __ATOMIC_RELAXED, __HIP_MEMORY_SCOPE_AGENT
#define LDS_WAIT() asm volatile("s_waitcnt lgkmcnt(0)" ::: "memory")
#define VM_WAIT() asm volatile("s_waitcnt vmcnt(0)" ::: "memory")
__device__ __forceinline__ unsigned f2bf(float f) { unsigned u = __builtin_bit_cast(unsigned, f); return (u + 0x7fffu + ((u >> 16) & 1u)) >> 16; }
__device__ __forceinline__ unsigned pk2(float lo, float hi) { return f2bf(lo) | (f2bf(hi) << 16); }
__device__ __forceinline__ unsigned cvt_pk_bf16(float lo, float hi) { unsigned r; asm volatile("v_cvt_pk_bf16_f32 %0, %1, %2" : "=v"(r) : "v"(lo), "v"(hi)); return r; }
__device__ __forceinline__ float bf_lo(unsigned w) { return __builtin_bit_cast(float, w << 16); }
__device__ __forceinline__ float bf_hi(unsigned w) { return __builtin_bit_cast(float, w & 0xffff0000u); }
__device__ __forceinline__ int lane_id() { int r; asm volatile("v_mbcnt_lo_u32_b32 %0, -1, 0\n\tv_mbcnt_hi_u32_b32 %0, -1, %0" : "=v"(r)); return r; }
template <class P> __device__ __forceinline__ P* opaque_p(P* p) { asm volatile("" : "+s"(p)); return p; }
__device__ __forceinline__ int opaque_s(int v) { asm volatile("" : "+s"(v)); return v; }
__device__ __forceinline__ int opaque(int v) { asm volatile("" : "+v"(v)); return v; }
__device__ __forceinline__ unsigned pk4_fp8(float a, float b, float c, float d) {
    int w = 0; w = __builtin_amdgcn_cvt_pk_fp8_f32(a, b, w, false); w = __builtin_amdgcn_cvt_pk_fp8_f32(c, d, w, true); return (unsigned)w; }
typedef float f32x2v __attribute__((ext_vector_type(2)));
__device__ __forceinline__ u32x2 fp8x4_to_bf16x4(unsigned w, float s) {
    const f32x2v a = __builtin_amdgcn_cvt_pk_f32_fp8((int)w, false), b = __builtin_amdgcn_cvt_pk_f32_fp8((int)w, true);
    u32x2 r; r.x = cvt_pk_bf16(a[0] * s, a[1] * s); r.y = cvt_pk_bf16(b[0] * s, b[1] * s); return r; }
__device__ __forceinline__ float max3f(float a, float b, float c) { float r; asm("v_max3_f32 %0, %1, %2, %3" : "=v"(r) : "v"(a), "v"(b), "v"(c)); return r; }
__device__ __forceinline__ float fast_exp2(float x) { return __builtin_amdgcn_exp2f(x); }
__device__ __forceinline__ float fast_rcp(float x) { return __builtin_amdgcn_rcpf(x); }

#define XB_TMO      128
#define XB_XCNT(j)  (256  + 64 * (j))
#define XB_XSUB(j)  (1280 + 64 * (j))
#define XB_XGEN(j)  (2304 + 64 * (j))
#define XB_TOP      3328
#define XB_TOPGEN   3392
#define XCD_BAR_WORDS 3456
#define XB_SPIN_CAP (1u << 22)
__device__ __forceinline__ unsigned xb_ld(unsigned* p)              { return __hip_atomic_load(p, __ATOMIC_RELAXED, __HIP_MEMORY_SCOPE_AGENT); }
__device__ __forceinline__ unsigned xb_add(unsigned* p, unsigned v) { return __hip_atomic_fetch_add(p, v, __ATOMIC_RELAXED, __HIP_MEMORY_SCOPE_AGENT); }
__device__ __forceinline__ unsigned xb_xcc_id() { return (unsigned)__builtin_amdgcn_s_getreg((3 << 11) | 20) & 0xFu; }
#define XB_SPIN(cond, bar) do { unsigned _sp = 0; while (cond) { __builtin_amdgcn_s_sleep(1); \
    if ((++_sp & 255u) == 0u) { if (xb_ld(&(bar)[XB_TMO])) break; if (_sp > XB_SPIN_CAP) { atomicAdd(&(bar)[XB_TMO], 1u); break; } } } } while (0)
struct XcdBarrier { unsigned* bar; unsigned x; volatile LAS unsigned* st; };
__device__ __forceinline__ XcdBarrier xcd_barrier_post(unsigned* bar, volatile LAS unsigned* st) {
    XcdBarrier b; b.bar = bar; b.x = xb_xcc_id(); b.st = st;
    if (threadIdx.x == 0) (void)xb_add(&bar[XB_XCNT(b.x)], 1u);
    return b;
}
__device__ __forceinline__ void xcd_barrier_complete(unsigned* bar, unsigned x, unsigned& nloc, unsigned& nx) {
    const unsigned G = gridDim.x * gridDim.y * gridDim.z;
    unsigned sum, cnt, mine, sp = 0u;
    for (;;) {
        sum = 0u; cnt = 0u; mine = 0u;
#pragma nounroll
        for (unsigned j = 0; j < 16; ++j) { const unsigned c = xb_ld(&bar[XB_XCNT(j)]); sum += c; cnt += (c > 0u) ? 1u : 0u; mine = (j == x) ? c : mine; }
        if (sum == G) break;
        __builtin_amdgcn_s_sleep(1);
        if ((++sp & 255u) == 0u) { if (xb_ld(&bar[XB_TMO])) break; if (sp > XB_SPIN_CAP) { atomicAdd(&bar[XB_TMO], 1u); break; } }
    }
    nloc = mine > 0u ? mine : 1u; nx = cnt > 0u ? cnt : 1u;
}
__device__ __forceinline__ void xcd_barrier(const XcdBarrier& b, const bool leader) {
    asm volatile("s_waitcnt vmcnt(0)" ::: "memory");
    __syncthreads();
    if (leader) {
        unsigned* bar = b.bar;
        __builtin_amdgcn_s_waitcnt(0);
        unsigned nloc = b.st[0], nx = b.st[1];
        if (nloc == 0u) { xcd_barrier_complete(bar, b.x, nloc, nx); b.st[0] = nloc; b.st[1] = nx; }
        const unsigned old = xb_add(&bar[XB_XSUB(b.x)], 1u);
        const unsigned gen = old / nloc;
        if (old + 1u == (gen + 1u) * nloc) {
            __builtin_amdgcn_fence(__ATOMIC_RELEASE, "agent");
            asm volatile("s_waitcnt vmcnt(0)" ::: "memory");
            const unsigned og = xb_add(&bar[XB_TOP], 1u);
            const unsigned tg = og / nx;
            if (og + 1u == (tg + 1u) * nx) xb_add(&bar[XB_TOPGEN], 1u);
            else XB_SPIN(xb_ld(&bar[XB_TOPGEN]) == tg, bar);
            __builtin_amdgcn_fence(__ATOMIC_ACQUIRE, "agent");
            xb_add(&bar[XB_XGEN(b.x)], 1u);
            asm volatile("s_waitcnt vmcnt(0)" ::: "memory");
        } else {
            XB_SPIN(xb_ld(&bar[XB_XGEN(b.x)]) == gen, bar);
            __builtin_amdgcn_fence(__ATOMIC_ACQUIRE, "agent");
            asm volatile("s_waitcnt vmcnt(0)" ::: "memory");
        }
    }
    __syncthreads();
}

__device__ __forceinline__ void glds16(const char* sbase, unsigned voff, unsigned lds_dst) { unsigned keep;
    asm volatile("s_mov_b32 %0, m0\n\ts_mov_b32 m0, %3\n\ts_nop 0\n\tglobal_load_lds_dwordx4 %1, %2\n\ts_mov_b32 m0, %0" : "=&s"(keep) : "v"(voff), "s"(sbase), "s"(lds_dst) : "memory"); }

namespace pg8 {
constexpr int BM = 256, BK = 64, HALF = 128, HTB = HALF * BK * 2, STAGE_BYTES = 8 * HTB, NXCD = 8, WGM = 8;
__host__ __device__ __forceinline__ int lds_byte(int r, int c) { const int st = (r >> 4) * 2 + (c >> 5), rr = r & 15, cc = c & 31, ob = rr * 64 + cc * 2; return st * 1024 + (ob ^ (((ob >> 9) & 1) << 5)); }
__host__ __device__ __forceinline__ void stage_rc(int b, int& R, int& C) { const int st = b / 1024, sb = b % 1024, swz = sb ^ (((sb >> 9) & 1) << 5); R = (st >> 1) * 16 + swz / 64; C = (st & 1) * 32 + (swz % 64) / 2; }
__host__ __device__ __forceinline__ int perm32(int rho) { const int n = rho >> 4, i = rho & 15; return 8 * (i >> 2) + 4 * n + (i & 3); }

struct Unit {
    const char* A;
    const char* B;
    const char* B2;
    const u32x4* rows;
    int nvalid, pm, pn, tile, sub;
};
struct Gemm { int lda, ldb, K, ksplit; unsigned hstepB; const char* aux; int mixk; };

struct StaticOrder {
    const char* A; const char* Bt; int lda, ldb;
    int nM, nN, nwg, G, c, abase;
    __device__ void init(const void* A_, const void* Bt_, int lda_, int ldb_, int M, int N, int G_, int c_, int abase_) { A = (const char*)A_; Bt = (const char*)Bt_; lda = lda_; ldb = ldb_; nM = M / BM; nN = N / BM; nwg = nM * nN; G = G_; c = c_; abase = abase_; }
    __device__ bool next(int i, Unit& u) const {
        const int L = i * G + c; if (L >= nwg) return false;
        int wgid = L; { const int q = nwg / NXCD, r = nwg % NXCD, xcd = wgid % NXCD, off = wgid / NXCD; wgid = (xcd < r ? xcd * (q + 1) : r * (q + 1) + (xcd - r) * q) + off; }
        const int nig = WGM * nN, gid = wgid / nig, fm = gid * WGM, gsz = (nM - fm) < WGM ? (nM - fm) : WGM;
        u.pm = fm + ((wgid % nig) % gsz); u.pn = (wgid % nig) / gsz;
        u.A = abase ? A : A + (size_t)u.pm * BM * lda * 2; u.B = Bt + (size_t)u.pn * BM * ldb * 2; u.B2 = u.B; u.rows = nullptr; u.nvalid = BM; u.tile = u.pm; u.sub = u.pn;
        return true;
    }
};

constexpr int ETAB_OFF = 131072, ETAB_BYTES = 4096;
typedef int i32x8 __attribute__((ext_vector_type(8)));
typedef int i32x4v __attribute__((ext_vector_type(4)));
template <class Epi, class Sched, bool ETAB, int GATHER, bool SPLITK, int FP8, bool SSQP = false>
__device__ __forceinline__ void gemm_phase(LAS unsigned char* lds, const int wid_in, const Gemm g, const Sched& S, const Epi& E) {
    const int wid = opaque_s(wid_in);
    const int lane = lane_id(), tid = wid * 64 + lane, wr = wid >> 2, wc = wid & 3, fr = lane & 15, fq = lane >> 4;
    const int nt = opaque_s(g.K / BK);
    unsigned cvA[2][2], voffB[2];
#pragma unroll
    for (int i = 0; i < 2; ++i) { int R, C; stage_rc(tid * 16 + i * 8192, R, C); const int Rb = Epi::PERM ? ((R & ~31) + perm32(R & 31)) : R;
        voffB[i] = (unsigned)(Rb * g.ldb + C) * 2u;
#pragma unroll
        for (int h = 0; h < 2; ++h) cvA[h][i] = (unsigned)((R + h * HALF) * g.lda + C) * 2u; }
    const size_t kstep = (size_t)(BK * 2);
    const size_t hstepB = g.hstepB;
    const unsigned ldsw = (unsigned)wid * 1024u, ldsb = (unsigned)(size_t)lds;
    const int aoff = lds_byte(wr * 64 + fr, fq * 8), boff = lds_byte(wc * 32 + fr, fq * 8);
#define PG8_SA(b, h) (((b) * 2 + (h)) * HTB)
#define PG8_SB(b, h) ((4 + (b) * 2 + (h)) * HTB)
#define PG8_STAGE(bufoff, gbase, v0, v1) do { glds16((const char*)(gbase), (v0), ldsb + (unsigned)(bufoff) + ldsw); glds16((const char*)(gbase), (v1), ldsb + (unsigned)(bufoff) + ldsw + 8192u); } while (0)
#define PG8_LD16(off) (*(const LAS i32x4v*)(lds + (off)))
#define PG8_LDA(dst, b, h) do { if constexpr (FP8 != 0) { _Pragma("unroll") for (int m = 0; m < 4; ++m) dst##8[m] = __builtin_shufflevector(PG8_LD16(PG8_SA(b, h) + aoff + m * 2048), PG8_LD16(PG8_SA(b, h) + aoff + m * 2048 + 1024), 0, 1, 2, 3, 4, 5, 6, 7); } \
        else { _Pragma("unroll") for (int m = 0; m < 4; ++m) _Pragma("unroll") for (int k = 0; k < 2; ++k) dst[m][k] = *(const LAS bf16x8*)(lds + PG8_SA(b, h) + aoff + m * 2048 + k * 1024); } } while (0)
#define PG8_LDB(dst, b, h) do { if constexpr (FP8 != 0) { _Pragma("unroll") for (int n = 0; n < 2; ++n) dst##8[n] = __builtin_shufflevector(PG8_LD16(PG8_SB(b, h) + boff + n * 2048), PG8_LD16(PG8_SB(b, h) + boff + n * 2048 + 1024), 0, 1, 2, 3, 4, 5, 6, 7); } \
        else { _Pragma("unroll") for (int n = 0; n < 2; ++n) _Pragma("unroll") for (int k = 0; k < 2; ++k) dst[n][k] = *(const LAS bf16x8*)(lds + PG8_SB(b, h) + boff + n * 2048 + k * 1024); } } while (0)
#define PG8_H0(x) __builtin_bit_cast(bf16x8, __builtin_shufflevector(x, x, 0, 1, 2, 3))
#define PG8_H1(x) __builtin_bit_cast(bf16x8, __builtin_shufflevector(x, x, 4, 5, 6, 7))
#define PG8_MMA(ai, bj, At, Bt, F8_) do { __builtin_amdgcn_s_setprio(1); \
        if constexpr ((F8_) == 1) { _Pragma("unroll") for (int m = 0; m < 4; ++m) _Pragma("unroll") for (int n = 0; n < 2; ++n) \
            acc[ai][bj][m][n] = __builtin_amdgcn_mfma_scale_f32_16x16x128_f8f6f4(Bt##8[n], At##8[m], acc[ai][bj][m][n], 0, 0, 0, 0, 0, 0); } \
        else if constexpr (FP8 != 0) { _Pragma("unroll") for (int m = 0; m < 4; ++m) _Pragma("unroll") for (int n = 0; n < 2; ++n) { \
            acc[ai][bj][m][n] = __builtin_amdgcn_mfma_f32_16x16x32_bf16(PG8_H0(Bt##8[n]), PG8_H0(At##8[m]), acc[ai][bj][m][n], 0, 0, 0); \
            acc[ai][bj][m][n] = __builtin_amdgcn_mfma_f32_16x16x32_bf16(PG8_H1(Bt##8[n]), PG8_H1(At##8[m]), acc[ai][bj][m][n], 0, 0, 0); } } \
        else { _Pragma("unroll") for (int m = 0; m < 4; ++m) _Pragma("unroll") for (int n = 0; n < 2; ++n) _Pragma("unroll") for (int k = 0; k < 2; ++k) \
            acc[ai][bj][m][n] = __builtin_amdgcn_mfma_f32_16x16x32_bf16(Bt[n % (FP8 != 0 ? 1 : 2)][k], At[m % (FP8 != 0 ? 1 : 4)][k], acc[ai][bj][m][n], 0, 0, 0); } __builtin_amdgcn_s_setprio(0); } while (0)
#define PG8_WAIT_V(n) asm volatile("s_waitcnt vmcnt(" #n ")" ::: "memory")
#define PG8_WAIT_L(n) asm volatile("s_waitcnt lgkmcnt(" #n ")" ::: "memory")
#define PG8_BAR __builtin_amdgcn_s_barrier()
#define PG8_SCHED __builtin_amdgcn_sched_barrier(0)
#define PG8_ETAB_DMA(U, BUF) do { if (wid < 4) { int e_ = wid * 64 + lane; e_ = e_ < (U).nvalid ? e_ : (U).nvalid - 1; \
        glds16((const char*)(U).rows, (unsigned)e_ * 16u, ldsb + (unsigned)(ETAB_OFF + (BUF) * ETAB_BYTES) + ldsw); } } while (0)
#define PG8_GATHER_HALF(H, BUF, U) do { const int t2_ = wid * 64 + opaque(lane); _Pragma("unroll") for (int i = 0; i < 2; ++i) { int R_, C_; stage_rc(t2_ * 16 + i * 8192, R_, C_); \
        const unsigned tok_ = GATHER == 2 ? (unsigned)((U).tile * BM + R_ + (H) * HALF) : *(const LAS unsigned*)(lds + ETAB_OFF + (BUF) * ETAB_BYTES + (R_ + (H) * HALF) * 16); cvA[H][i] = (tok_ * (unsigned)g.lda + (unsigned)C_) * 2u; } } while (0)
    Unit cur, nxt; int ui = 0;
    if (!S.next(0, cur)) return;
    f32x4 acc[2][2][4][2];
#pragma unroll
    for (int a = 0; a < 2; ++a)
#pragma unroll
        for (int b = 0; b < 2; ++b)
#pragma unroll
            for (int m = 0; m < 4; ++m)
#pragma unroll
                for (int n = 0; n < 2; ++n) acc[a][b][m][n] = (f32x4){0.f, 0.f, 0.f, 0.f};
    bf16x8 At[FP8 != 0 ? 1 : 4][2], B0[FP8 != 0 ? 1 : 2][2], B1[FP8 != 0 ? 1 : 2][2];
    i32x8 At8[FP8 != 0 ? 4 : 1], B08[FP8 != 0 ? 2 : 1], B18[FP8 != 0 ? 2 : 1];
    (void)At; (void)B0; (void)B1; (void)At8; (void)B08; (void)B18;
    if constexpr (ETAB) { PG8_ETAB_DMA(cur, 0); PG8_WAIT_V(0); PG8_BAR; }
    if constexpr (GATHER != 0) { PG8_GATHER_HALF(0, 0, cur); PG8_GATHER_HALF(1, 0, cur); }
    const char* cA = cur.A; const char* cB = cur.B; const char* cB2 = cur.B2;
    PG8_STAGE(PG8_SB(0, 0), cB, voffB[0], voffB[1]); PG8_STAGE(PG8_SB(0, 1), cB + hstepB, voffB[0], voffB[1]); PG8_STAGE(PG8_SA(0, 0), cA, cvA[0][0], cvA[0][1]); PG8_STAGE(PG8_SA(0, 1), cA, cvA[1][0], cvA[1][1]);
    if (wr == 1) PG8_BAR;
    PG8_WAIT_V(2); PG8_BAR;
    PG8_STAGE(PG8_SB(1, 0), cB + kstep, voffB[0], voffB[1]); PG8_STAGE(PG8_SA(1, 0), cA + kstep, cvA[0][0], cvA[0][1]); PG8_STAGE(PG8_SB(1, 1), cB + hstepB + kstep, voffB[0], voffB[1]);
    PG8_WAIT_V(6); PG8_BAR;
    for (;;) {
        const bool has_next = S.next(ui + 1, nxt);
        const int ebn = (ui + 1) % 3;
        if constexpr (ETAB) { if (has_next) { PG8_ETAB_DMA(nxt, ebn); } }
        const char* nA = has_next ? nxt.A : cA; const char* nB = has_next ? nxt.B : cB;
#define PG8_KTRIP(F8T) { \
            const bool last = (t == nt - 2); \
            const char* a1 = cA + (size_t)(t + 1) * kstep; \
            const char* a2 = last ? nA : cA + (size_t)(t + 2) * kstep; \
            const char* bcur = (SPLITK && (t + 2) >= g.ksplit) ? cB2 : cB; \
            const char* b2 = last ? nB : bcur + (size_t)(t + 2) * kstep; \
            const char* a3 = a2 + kstep; const char* b3 = b2 + kstep; \
            if constexpr (GATHER != 0) { if (last && has_next) { PG8_GATHER_HALF(0, ebn, nxt); } } \
            if constexpr (SSQP) { if (t == 2) { const char* sp_ = g.aux + (size_t)cur.pm * 16384; glds16(sp_, (unsigned)(wid * 2048 + lane * 16), ldsb + (unsigned)ETAB_OFF + (unsigned)wid * 2048u); glds16(sp_, (unsigned)(wid * 2048 + 1024 + lane * 16), ldsb + (unsigned)ETAB_OFF + (unsigned)wid * 2048u + 1024u); } } \
            PG8_LDB(B0, 0, 0); PG8_LDB(B1, 0, 1); PG8_SCHED; PG8_LDA(At, 0, 0); PG8_STAGE(PG8_SA(1, 1), a1, cvA[1][0], cvA[1][1]); \
            if constexpr (GATHER != 0) { if (last && has_next) { PG8_GATHER_HALF(1, ebn, nxt); } } \
            PG8_WAIT_V(8); PG8_WAIT_L(0); PG8_BAR; PG8_MMA(0, 0, At, B0, F8T); PG8_MMA(0, 1, At, B1, F8T); PG8_BAR; PG8_SCHED; \
            PG8_LDA(At, 0, 1); PG8_STAGE(PG8_SB(0, 0), b2, voffB[0], voffB[1]); PG8_STAGE(PG8_SB(0, 1), b2 + hstepB, voffB[0], voffB[1]); PG8_STAGE(PG8_SA(0, 0), a2, cvA[0][0], cvA[0][1]); \
            PG8_WAIT_V(8); PG8_WAIT_L(0); PG8_BAR; PG8_MMA(1, 0, At, B0, F8T); PG8_MMA(1, 1, At, B1, F8T); PG8_BAR; PG8_SCHED; \
            PG8_LDB(B0, 1, 0); PG8_LDB(B1, 1, 1); PG8_SCHED; PG8_LDA(At, 1, 0); PG8_STAGE(PG8_SA(0, 1), a2, cvA[1][0], cvA[1][1]); \
            PG8_WAIT_V(8); PG8_WAIT_L(0); PG8_BAR; PG8_MMA(0, 0, At, B0, F8T); PG8_MMA(0, 1, At, B1, F8T); PG8_BAR; PG8_SCHED; \
            PG8_LDA(At, 1, 1); PG8_STAGE(PG8_SB(1, 0), b3, voffB[0], voffB[1]); PG8_STAGE(PG8_SB(1, 1), b3 + hstepB, voffB[0], voffB[1]); PG8_STAGE(PG8_SA(1, 0), a3, cvA[0][0], cvA[0][1]); \
            PG8_WAIT_V(8); PG8_WAIT_L(0); PG8_BAR; PG8_MMA(1, 0, At, B0, F8T); PG8_MMA(1, 1, At, B1, F8T); PG8_BAR; PG8_SCHED; }
        int t = 0;
        if constexpr (FP8 == 2) {
#pragma nounroll
            for (; t < g.mixk; t += 2) PG8_KTRIP(1)
#pragma nounroll
            for (; t < nt; t += 2) PG8_KTRIP(0)
        } else {
#pragma nounroll
            for (; t < nt; t += 2) PG8_KTRIP(FP8)
        }
#undef PG8_KTRIP
        if (wr == 0) PG8_BAR;
        { const int eoff = opaque_s(SSQP ? ETAB_OFF : ETAB_OFF + (ui % 3) * ETAB_BYTES);
          E(acc, cur, wr, wc, fr, fq, (const LAS u32x4*)(lds + eoff)); }
        if (!has_next) break;
#pragma unroll
        for (int a = 0; a < 2; ++a)
#pragma unroll
            for (int b = 0; b < 2; ++b)
#pragma unroll
                for (int m = 0; m < 4; ++m)
#pragma unroll
                    for (int n = 0; n < 2; ++n) acc[a][b][m][n] = (f32x4){0.f, 0.f, 0.f, 0.f};
        cur = nxt; cA = nA; cB = nB; cB2 = nxt.B2; ++ui;
        if (wr == 1) PG8_BAR;
    }
    PG8_WAIT_V(0);
    PG8_BAR;
#undef PG8_SA
#undef PG8_SB
#undef PG8_STAGE
#undef PG8_LDA
#undef PG8_LDB
#undef PG8_MMA
#undef PG8_LD16
#undef PG8_H0
#undef PG8_H1
#undef PG8_WAIT_V
#undef PG8_WAIT_L
#undef PG8_BAR
#undef PG8_SCHED
#undef PG8_ETAB_DMA
#undef PG8_GATHER_HALF
}


struct EpiProj {
    static constexpr bool PERM = true;
    bf16* O; const float* ssq; int coff; float sc_q, sc_o; unsigned char* O8;
    __device__ __forceinline__ void operator()(const f32x4 (&acc)[2][2][4][2], const Unit& u, int wr, int wc, int fr_, int fq_, const LAS u32x4* et) const {
        const int fr = opaque(fr_), fq = opaque(fq_);
        const int row0 = u.pm * BM + wr * 64 + fr, col0 = coff + u.pn * BM + wc * 32 + 8 * fq; const float scx = u.pn < 2 ? sc_q : sc_o;
#pragma unroll
        for (int ai = 0; ai < 2; ++ai)
#pragma unroll
            for (int m = 0; m < 4; ++m) { const int row = row0 + ai * HALF + m * 16;
                const LAS f32x4* sp = (const LAS f32x4*)et + (ai * HALF + wr * 64 + m * 16 + fr) * 4; const f32x4 s0 = sp[0], s1 = sp[1], s2 = sp[2], s3 = sp[3];
                const f32x4 st = (s0 + s1) + (s2 + s3); const float rs = __builtin_amdgcn_rsqf(((st[0] + st[1]) + (st[2] + st[3])) * (1.0f / D) + EPS) * scx;
                bf16* rowp = O + (size_t)row * DIN + col0; unsigned char* rowp8 = O8 + (size_t)row * 1536 + col0;
#pragma unroll
                for (int bj = 0; bj < 2; ++bj) { const f32x4 v0 = acc[ai][bj][m][0] * rs, v1 = acc[ai][bj][m][1] * rs;
                    if (O8) { u32x2 w8; w8.x = pk4_fp8(v0[0], v0[1], v0[2], v0[3]); w8.y = pk4_fp8(v1[0], v1[1], v1[2], v1[3]); *(u32x2*)(rowp8 + bj * HALF) = w8; }
                    else { u32x4 w; w.x = cvt_pk_bf16(v0[0], v0[1]); w.y = cvt_pk_bf16(v0[2], v0[3]); w.z = cvt_pk_bf16(v1[0], v1[1]); w.w = cvt_pk_bf16(v1[2], v1[3]);
                        *(u32x4*)(rowp + bj * HALF) = w; } } }
    }
};
struct EpiRes {
    static constexpr bool PERM = true;
    bf16* xb; unsigned char* x8;
    __device__ __forceinline__ void operator()(const f32x4 (&acc)[2][2][4][2], const Unit& u, int wr, int wc, int fr_, int fq_, const LAS u32x4* et) const {
        const int fr = opaque(fr_), fq = opaque(fq_);
        const int row0 = u.pm * BM + wr * 64 + fr, col0 = u.pn * BM + wc * 32 + 8 * fq;
        float DS = 1.0f / (SC_A8 * SC_WGU); asm volatile("" : "+v"(DS));
#pragma unroll
        for (int ai = 0; ai < 2; ++ai) {
            u32x4 xo[4][2];
#pragma unroll
            for (int m = 0; m < 4; ++m)
#pragma unroll
                for (int bj = 0; bj < 2; ++bj) xo[m][bj] = *(const u32x4*)(xb + (size_t)(row0 + ai * HALF + m * 16) * D + col0 + bj * HALF);
            asm volatile("" ::: "memory");
#pragma unroll
            for (int m = 0; m < 4; ++m) { const size_t ro = (size_t)(row0 + ai * HALF + m * 16) * D + col0;
#pragma unroll
                for (int bj = 0; bj < 2; ++bj) { const u32x4 w0 = xo[m][bj]; const f32x4 a0 = acc[ai][bj][m][0], a1 = acc[ai][bj][m][1]; u32x4 w;
                    const float v0 = __builtin_fmaf(a0[0], DS, bf_lo(w0.x)), v1 = __builtin_fmaf(a0[1], DS, bf_hi(w0.x)), v2 = __builtin_fmaf(a0[2], DS, bf_lo(w0.y)), v3 = __builtin_fmaf(a0[3], DS, bf_hi(w0.y)), v4 = __builtin_fmaf(a1[0], DS, bf_lo(w0.z)), v5 = __builtin_fmaf(a1[1], DS, bf_hi(w0.z)), v6 = __builtin_fmaf(a1[2], DS, bf_lo(w0.w)), v7 = __builtin_fmaf(a1[3], DS, bf_hi(w0.w));
                    w.x = cvt_pk_bf16(v0, v1); w.y = cvt_pk_bf16(v2, v3); w.z = cvt_pk_bf16(v4, v5); w.w = cvt_pk_bf16(v6, v7);
                    *(u32x4*)(xb + ro + bj * HALF) = w;
                    u32x2 q8; q8.x = pk4_fp8(v0 * SC_X8, v1 * SC_X8, v2 * SC_X8, v3 * SC_X8); q8.y = pk4_fp8(v4 * SC_X8, v5 * SC_X8, v6 * SC_X8, v7 * SC_X8);
                    *(u32x2*)(x8 + ro + bj * HALF) = q8; } }
            asm volatile("" ::: "memory"); }
    }
};
struct EpiSwiglu {
    static constexpr bool PERM = true;
    unsigned char* H;
    __device__ __forceinline__ void operator()(const f32x4 (&acc)[2][2][4][2], const Unit& u, int wr, int wc, int fr_, int fq_, const LAS u32x4* et) const {
        const int fr = opaque(fr_), fq = opaque(fq_);
        const int ehalf = u.sub >> 2, jblk = u.sub & 3;
        const int col0 = ehalf * DE + jblk * HALF + wc * 32 + 8 * fq;
#pragma unroll
        for (int ai = 0; ai < 2; ++ai)
#pragma unroll
            for (int m = 0; m < 4; ++m) { const int lr = ai * HALF + wr * 64 + m * 16 + fr;
                const u32x4 e = et[lr]; const unsigned ey = e.y, ew = ehalf ? e.w : e.z;
                const float rs = __uint_as_float(ey), w = __uint_as_float(ew);
                float hv[8];
#pragma unroll
                for (int n = 0; n < 2; ++n)
#pragma unroll
                    for (int k = 0; k < 4; ++k) { const float gt = acc[ai][0][m][n][k] * rs, up = acc[ai][1][m][n][k] * rs;
                        const float sg = gt * fast_rcp(1.0f + fast_exp2(-LOG2E * gt)); hv[n * 4 + k] = sg * up * w; }
                u32x2 o; o.x = pk4_fp8(hv[0], hv[1], hv[2], hv[3]); o.y = pk4_fp8(hv[4], hv[5], hv[6], hv[7]);
                *(u32x2*)(H + (size_t)(u.tile * BM + lr) * D + col0) = o; }
    }
};
struct EpiScatter {
    static constexpr bool PERM = true;
    bf16* xb; float* ssq; unsigned char* x8;
    __device__ __forceinline__ void operator()(const f32x4 (&acc)[2][2][4][2], const Unit& u, int wr, int wc, int fr_, int fq_, const LAS u32x4* et) const {
        const int fr = opaque(fr_), fq = opaque(fq_);
        const int col0 = u.pn * BM + wc * 32 + 8 * fq;
        float DS = 1.0f / (SC_H8 * SC_WD); asm volatile("" : "+v"(DS));
#pragma unroll
        for (int ai = 0; ai < 2; ++ai) {
            unsigned tok[4]; u32x4 xo[4][2];
#pragma unroll
            for (int m = 0; m < 4; ++m) tok[m] = et[ai * HALF + wr * 64 + m * 16 + fr].x;
#pragma unroll
            for (int m = 0; m < 4; ++m)
#pragma unroll
                for (int bj = 0; bj < 2; ++bj) xo[m][bj] = *(const u32x4*)(xb + (size_t)tok[m] * D + col0 + bj * HALF);
            asm volatile("" ::: "memory");
#pragma unroll
            for (int m = 0; m < 4; ++m) { const int lr = ai * HALF + wr * 64 + m * 16 + fr; const bool valid = lr < u.nvalid; const size_t ro = (size_t)tok[m] * D + col0; float ss = 0.f;
#pragma unroll
                for (int bj = 0; bj < 2; ++bj) { const u32x4 w0 = xo[m][bj]; const f32x4 a0 = acc[ai][bj][m][0], a1 = acc[ai][bj][m][1]; u32x4 w;
                    w.x = cvt_pk_bf16(__builtin_fmaf(a0[0], DS, bf_lo(w0.x)), __builtin_fmaf(a0[1], DS, bf_hi(w0.x))); w.y = cvt_pk_bf16(__builtin_fmaf(a0[2], DS, bf_lo(w0.y)), __builtin_fmaf(a0[3], DS, bf_hi(w0.y)));
                    w.z = cvt_pk_bf16(__builtin_fmaf(a1[0], DS, bf_lo(w0.z)), __builtin_fmaf(a1[1], DS, bf_hi(w0.z))); w.w = cvt_pk_bf16(__builtin_fmaf(a1[2], DS, bf_lo(w0.w)), __builtin_fmaf(a1[3], DS, bf_hi(w0.w)));
                    const float r0 = bf_lo(w.x), r1 = bf_hi(w.x), r2 = bf_lo(w.y), r3 = bf_hi(w.y), r4 = bf_lo(w.z), r5 = bf_hi(w.z), r6 = bf_lo(w.w), r7 = bf_hi(w.w);
                    ss += ((r0 * r0 + r1 * r1) + (r2 * r2 + r3 * r3)) + ((r4 * r4 + r5 * r5) + (r6 * r6 + r7 * r7));
                    if (valid) { *(u32x4*)(xb + ro + bj * HALF) = w; u32x2 q8; q8.x = pk4_fp8(r0 * SC_X8, r1 * SC_X8, r2 * SC_X8, r3 * SC_X8); q8.y = pk4_fp8(r4 * SC_X8, r5 * SC_X8, r6 * SC_X8, r7 * SC_X8);
                        *(u32x2*)(x8 + ro + bj * HALF) = q8; } }
                ss += __shfl_xor(ss, 16); ss += __shfl_xor(ss, 32);
                if (valid && fq == 0) ssq[(size_t)tok[m] * 16 + u.pn * 4 + wc] = ss; }
            asm volatile("" ::: "memory"); }
    }
};
}

template <int SUB> struct MoeOrder {
    const volatile LAS int* tb;
    const volatile LAS int* cnt;
    int nunits, G, c;
    const char* A; const char* W; const u32x4* list;
    __device__ __forceinline__ bool next(int i, pg8::Unit& u) const {
        const int L = i * G + c; if (L >= nunits) return false;
        const int tile = L / SUB, sub = L % SUB;
        int k = 0; while (tb[k + 1] <= tile) ++k;
        const int tin = tile - tb[k]; const int rem = cnt[k] - tin * 256;
        u.nvalid = rem < 256 ? rem : 256; u.rows = list + (size_t)k * T + (size_t)tin * 256; u.tile = tile; u.sub = sub; u.pm = tile;
        const int gi = k / 6, p = k % 6; const int a = p < 3 ? 0 : (p < 5 ? 1 : 2); const int b = p < 3 ? p + 1 : (p < 5 ? p - 1 : 3);
        const int ea = gi * 4 + a, eb = gi * 4 + b;
        if (SUB == 8) {
            const int ehalf = sub >> 2, jblk = sub & 3; u.pn = sub; u.A = A;
            u.B = W + ((size_t)(ehalf ? eb : ea) * 1024 + (size_t)jblk * 128) * (size_t)D; u.B2 = u.B;
        } else {
            u.pn = sub; u.A = A;
            u.B = W + ((size_t)ea * 1024 + (size_t)sub * 256) * (size_t)DE;
            u.B2 = W + ((size_t)eb * 1024 + (size_t)sub * 256) * (size_t)DE - (size_t)4 * 128;
        }
        return true;
    }
};

__device__ __forceinline__ float wave_sum(float v) {
#pragma unroll
    for (int o = 1; o < 64; o <<= 1) v += __shfl_xor(v, o);
    return v;
}
__device__ __forceinline__ void weff_task(const float* pw, const float* ps, const float* wo, unsigned char* WT, int g, int kb8, int n0, int lane) {
    const float* wog = wo + (size_t)(512 + g * 128) * D + n0 + lane; const float* psg = ps + g * 128; const float* pr = pw + ((size_t)g * 128 + kb8 * 8) * 128;
    float a[8];
#pragma unroll
    for (int q = 0; q < 8; ++q) a[q] = 0.f;
    for (int j0 = 0; j0 < 128; j0 += 32) { float wv[32];
#pragma unroll
        for (int jj = 0; jj < 32; ++jj) wv[jj] = wog[(size_t)(j0 + jj) * D];
#pragma unroll
        for (int jj = 0; jj < 32; ++jj) { const float sw = wv[jj] * psg[j0 + jj];
#pragma unroll
            for (int q = 0; q < 8; ++q) a[q] += pr[q * 128 + j0 + jj] * sw; } }
    constexpr float WS_ = SC_A8 * SC_WGU;
    u32x4 o; o.x = pk2(a[0] * WS_, a[1] * WS_); o.y = pk2(a[2] * WS_, a[3] * WS_); o.z = pk2(a[4] * WS_, a[5] * WS_); o.w = pk2(a[6] * WS_, a[7] * WS_);
    *(u32x4*)(WT + (size_t)(n0 + lane) * MIXP + 512 + (size_t)(g * 128 + kb8 * 8) * 2) = o;
}

#define CONVERT_WEIGHTS(Q0_, Q1_, GW_, NGW_) { \
        constexpr int I_IN = 16 * 64, I_OT = 8 * 32, I_G = 16 * 16, I_D = 8 * 32; \
        constexpr int PER_LAYER = I_IN + I_OT + NE * (2 * I_G + I_D); const int cfirst_ = (Q0_) * (PER_LAYER / 4) + (GW_), NCONV = (Q1_) * (PER_LAYER / 4); \
        struct Item { const float* W; const float* ks; unsigned char* dst; int ldw, k0, n0, pitch, f8; float ns; }; \
        auto decode = [&](int it) -> Item { Item I; const int l = it / PER_LAYER; int r = it % PER_LAYER; \
            if (r < I_IN) { const int kb = r / 64, nb = r % 64; I.W = w_in + (size_t)l * D * DIN; I.ldw = DIN; I.ks = norm_mix_g + l * D; I.k0 = 64 * kb; I.n0 = 32 * nb; \
                if (nb < 48) { I.dst = Win8 + (size_t)l * 1536 * D; I.pitch = D; I.f8 = 1; I.ns = SC_WGU; } \
                else { I.dst = (unsigned char*)(Win_t + (size_t)l * DIN * D); I.pitch = D * 2; I.f8 = 0; I.ns = 1.0f; } \
                return I; } r -= I_IN; \
            if (r < I_OT) { const int kb = r / 32, nb = r % 32; I.W = w_out + (size_t)l * D * D; I.ldw = D; I.ks = nullptr; I.k0 = 64 * kb; I.n0 = 32 * nb; I.dst = Wout8 + (size_t)l * D * MIXP; I.pitch = MIXP; I.f8 = 1; I.ns = SC_WGU; return I; } r -= I_OT; \
            const int e = r / (2 * I_G + I_D); r %= (2 * I_G + I_D); const size_t le = (size_t)l * NE + e; \
            if (r < 2 * I_G) { const int up = r >= I_G; r -= up * I_G; const int kb = r / 16, nb = r % 16; I.W = (up ? w_up : w_gate) + le * D * DE; I.ldw = DE; I.ks = norm_ffn_g + l * D; I.k0 = 64 * kb; I.n0 = 32 * nb; \
                I.dst = Wgu8 + le * 1024 * D + (size_t)(up ? 512 : 0) * D; I.pitch = D; I.f8 = 1; I.ns = SC_WGU; return I; } r -= 2 * I_G; \
            { const int kb = r / 32, nb = r % 32; I.W = w_down + le * DE * D; I.ldw = D; I.ks = nullptr; I.k0 = 64 * kb; I.n0 = 32 * nb; I.dst = Wd8 + le * 1024 * DE; I.pitch = DE; I.f8 = 1; I.ns = SC_WD; return I; } }; \
        float cur[32], nxt[32], nx2[32]; \
_Pragma("unroll") \
        for (int i = 0; i < 32; ++i) { cur[i] = 0.f; nxt[i] = 0.f; nx2[i] = 0.f; } \
        if (cfirst_ < NCONV) { const Item I = decode(cfirst_); \
_Pragma("unroll") \
            for (int i = 0; i < 32; ++i) cur[i] = I.W[(size_t)(I.k0 + 2 * i + (lane >> 5)) * I.ldw + I.n0 + (lane & 31)]; } \
        if (cfirst_ + (NGW_) < NCONV) { const Item I = decode(cfirst_ + (NGW_)); \
_Pragma("unroll") \
            for (int i = 0; i < 32; ++i) nxt[i] = I.W[(size_t)(I.k0 + 2 * i + (lane >> 5)) * I.ldw + I.n0 + (lane & 31)]; } \
        for (int it = cfirst_; it < NCONV; it += (NGW_)) { \
            const Item I = decode(it); \
            if (it + 2 * (NGW_) < NCONV) { const Item J = decode(it + 2 * (NGW_)); \
_Pragma("unroll") \
                for (int i = 0; i < 32; ++i) nx2[i] = J.W[(size_t)(J.k0 + 2 * i + (lane >> 5)) * J.ldw + J.n0 + (lane & 31)]; } \
_Pragma("unroll") \
            for (int i = 0; i < 32; ++i) { const int kk = 2 * i + (lane >> 5); float v = cur[i]; if (I.ks) v *= I.ks[I.k0 + kk]; scr[kk * 33 + (lane & 31)] = v * I.ns; } \
            LDS_WAIT(); asm volatile("" ::: "memory"); \
            const int c = lane & 7; \
_Pragma("unroll") \
            for (int j = 0; j < 4; ++j) { const int n = (lane >> 3) + 8 * j; const LAS float* s = scr + (8 * c) * 33 + n; \
                if (I.f8) { u32x2 o; o.x = pk4_fp8(s[0 * 33], s[1 * 33], s[2 * 33], s[3 * 33]); o.y = pk4_fp8(s[4 * 33], s[5 * 33], s[6 * 33], s[7 * 33]); \
                    *(u32x2*)(I.dst + (size_t)(I.n0 + n) * I.pitch + I.k0 + 8 * c) = o; } \
                else { u32x4 o; o.x = pk2(s[0 * 33], s[1 * 33]); o.y = pk2(s[2 * 33], s[3 * 33]); o.z = pk2(s[4 * 33], s[5 * 33]); o.w = pk2(s[6 * 33], s[7 * 33]); \
                    *(u32x4*)(I.dst + (size_t)(I.n0 + n) * I.pitch + (size_t)(I.k0 + 8 * c) * 2) = o; } } \
            LDS_WAIT(); asm volatile("" ::: "memory"); \
_Pragma("unroll") \
            for (int i = 0; i < 32; ++i) { cur[i] = nxt[i]; nxt[i] = nx2[i]; } \
        } \
        for (int it = (Q0_) * 256 + (GW_); it < (Q1_) * 256; it += (NGW_)) { const int l = it >> 10, r = it & 1023, g = r >> 8, kb8 = (r >> 4) & 15, nc = r & 15; \
            weff_task(pool_w + (size_t)l * 4 * 128 * 128, pool_scale + l * 512, w_out + (size_t)l * D * D, Wout8 + (size_t)l * D * MIXP, g, kb8, 64 * nc, lane); } \
        for (int it = (Q0_) * 1024 + (GW_) * 64 + lane; it < (Q1_) * 1024; it += (NGW_) * 64) { \
            const int l = it >> 12, step = (it >> 6) & 63, ln = it & 63, m = ln & 31, kg = ln >> 5, kb = (step >> 2) * 64 + kg * 32 + (step & 3) * 8; \
            unsigned hw[4], lw[4]; \
_Pragma("unroll") \
            for (int jj = 0; jj < 4; ++jj) { float v[2]; \
_Pragma("unroll") \
                for (int q = 0; q < 2; ++q) { const int k = kb + 2 * jj + q; float w = 0.f; \
                    if (m < 8) w = w_rg[((size_t)l * D + k) * 4 + (m & 3)]; else if (m < 24) w = w_re[((size_t)l * D + k) * 16 + (m - 8)]; \
                    v[q] = w * norm_ffn_g[l * D + k]; } \
                const unsigned h = pk2(v[0], v[1]); hw[jj] = h; lw[jj] = pk2(v[0] - bf_lo(h), v[1] - bf_hi(h)); } \
            rfrag[(size_t)l * 8192 + (size_t)(0 * 64 + step) * 64 + ln] = (u32x4){hw[0], hw[1], hw[2], hw[3]}; \
            rfrag[(size_t)l * 8192 + (size_t)(1 * 64 + step) * 64 + ln] = (u32x4){lw[0], lw[1], lw[2], lw[3]}; \
        } }

struct Args { const float* in[14]; float* out; unsigned char* ws; int ph_lo, ph_hi, li, pad; };
constexpr int N_PHASES = 2 + 6 * DEPTH;

__global__ void __launch_bounds__(NTHREADS, 2) enc_fwd(Args args) {
    extern __shared__ __attribute__((aligned(16))) unsigned char lds_raw[];
    LAS unsigned char* lds = (LAS unsigned char*)lds_raw;
    volatile LAS unsigned* MISC = (volatile LAS unsigned*)(lds + MISC_OFF);
    const int wave_s = __builtin_amdgcn_readfirstlane((int)threadIdx.x >> 6);
    const int G = gridDim.x; const int bx = blockIdx.x; const int vcu = (G % 8 == 0) ? (bx % 8) * (G / 8) + bx / 8 : bx;
    unsigned char* ws = args.ws;
    gu32* ctl = (gu32*)(ws + WS_CTL);
    const float* x_in = args.in[0]; const float* norm_mix_g = args.in[1]; const float* w_in = args.in[2]; const float* rpb = args.in[3];
    const float* pool_w = args.in[4]; const float* pool_scale = args.in[5]; const float* w_out = args.in[6]; const float* norm_ffn_g = args.in[7];
    const float* w_rg = args.in[8]; const float* w_re = args.in[9]; const float* w_gate = args.in[10]; const float* w_up = args.in[11]; const float* w_down = args.in[12];
    const float* final_g = args.in[13];
#define WS_PTRS() GAS unsigned char* wsg_ = (GAS unsigned char*)ws; asm volatile("" : "+s"(wsg_)); unsigned char* wsp = (unsigned char*)wsg_;     \
    bf16* Win_t = (bf16*)(wsp + WS_WIN); bf16* Wout_t = (bf16*)(wsp + WS_WOUT); unsigned char* Wgu8 = wsp + WS_WGU; unsigned char* Wd8 = wsp + WS_WD; unsigned char* x8 = wsp + WS_X8; unsigned char* H8 = wsp + WS_H; unsigned char* Win8 = wsp + WS_WIN8; unsigned char* qkv8 = wsp + WS_QKV8; \
    u32x4* rfrag = (u32x4*)(wsp + WS_RFRAG); float* ssq = (float*)(wsp + WS_SSQ); u32x4* list = (u32x4*)(wsp + WS_LIST); \
    bf16* xb = (bf16*)(wsp + WS_XB); bf16* proj = (bf16*)(wsp + WS_PROJ); unsigned char* mix8 = wsp + WS_MIX; unsigned char* Wout8 = wsp + WS_WOUT; \
    (void)Win_t; (void)Win8; (void)qkv8; (void)Wout_t; (void)Wgu8; (void)Wd8; (void)x8; (void)H8; (void)rfrag; (void)ssq; (void)list; (void)xb; (void)proj; (void)mix8; (void)Wout8

    for (int u = threadIdx.x; u < 128; u += NTHREADS) MISC[u] = 0u;
    __syncthreads();
    XcdBarrier bar; bar.bar = (unsigned*)(ctl + CW_BAR); bar.x = 0; bar.st = nullptr;
    if (MK_N_LAUNCHES == 1) bar = xcd_barrier_post((unsigned*)(ctl + CW_BAR), MISC + MW_BAR);
    const int lo = args.ph_lo, hi = args.ph_hi;
#define IN(k) (lo <= (k) && (k) < hi)
#define SEAM(k) do { if (IN(k) && IN((k) + 1)) xcd_barrier(bar, wave_s == 0 && lane_id() == 0); } while (0)
    const int NGW = G * NWAVES;
#define PHASE_IDS() const int wave = opaque_s(wave_s), lane = lane_id(), tid = wave * 64 + lane, gw = opaque_s(vcu) * NWAVES + wave; (void)gw; (void)tid

    if (IN(0)) for (int rep_ = 0; rep_ < REP_P0; ++rep_) {
        WS_PTRS();
        PHASE_IDS();
        __syncthreads();
        LAS float* scr = (LAS float*)(lds + wave * 16384);
        CONVERT_WEIGHTS(0, 4, gw, NGW)
        for (int m0 = gw * 4; m0 < T; m0 += NGW * 4) {
            f32x4 v[4][4];
#pragma unroll
            for (int rr = 0; rr < 4; ++rr) { const f32x4* xr = (const f32x4*)(x_in + (size_t)(m0 + rr) * D) + lane;
#pragma unroll
                for (int j = 0; j < 4; ++j) v[rr][j] = xr[64 * j]; }
#pragma unroll
            for (int rr = 0; rr < 4; ++rr) { float s = 0.f;
#pragma unroll
                for (int j = 0; j < 4; ++j) s += (v[rr][j][0] * v[rr][j][0] + v[rr][j][1] * v[rr][j][1]) + (v[rr][j][2] * v[rr][j][2] + v[rr][j][3] * v[rr][j][3]);
                s = wave_sum(s);
                u32x2* o8 = (u32x2*)(xb + (size_t)(m0 + rr) * D) + lane;
#pragma unroll
                for (int j = 0; j < 4; ++j) { u32x2 w; w.x = cvt_pk_bf16(v[rr][j][0], v[rr][j][1]); w.y = cvt_pk_bf16(v[rr][j][2], v[rr][j][3]); o8[64 * j] = w;
                    ((unsigned*)(x8 + (size_t)(m0 + rr) * D))[lane + 64 * j] = pk4_fp8(v[rr][j][0] * SC_X8, v[rr][j][1] * SC_X8, v[rr][j][2] * SC_X8, v[rr][j][3] * SC_X8); }
                if (lane < 16) ssq[(size_t)(m0 + rr) * 16 + lane] = lane == 0 ? s : 0.f; }
        }
        LDS_WAIT();
    }
    SEAM(0);

    for (int l = 0; l < DEPTH; ++l) {
        const int pb = 1 + 6 * l;
        if (IN(pb)) for (int rep_ = 0; rep_ < REP_P1; ++rep_) {
        WS_PTRS();
            {
                pg8::Gemm g{D / 2, D / 2, D / 2, 1 << 20, (unsigned)(128 * D), (const char*)ssq};
                pg8::StaticOrder S; S.init(x8, Win8 + (size_t)l * 1536 * D, D / 2, D / 2, T, 1536, G, opaque_s(bx), 1);
                pg8::EpiProj E{proj, ssq, 0, SC_Q8 * 0.125f * LOG2E / (SC_X8 * SC_WGU), SC_KV8 / (SC_X8 * SC_WGU), qkv8};
                pg8::gemm_phase<pg8::EpiProj, pg8::StaticOrder, false, 2, false, true, true>(lds, wave_s, g, S, E); }
            {
                pg8::Gemm g{D, D, D, 1 << 20, (unsigned)(128 * D * 2), (const char*)ssq};
                pg8::StaticOrder S; S.init(xb, Win_t + ((size_t)l * DIN + 1536) * D, D, D, T, 512, G, opaque_s(bx), 0);
                pg8::EpiProj E{proj, ssq, 1536, 1.0f, 1.0f, nullptr};
                pg8::gemm_phase<pg8::EpiProj, pg8::StaticOrder, false, 0, false, false, true>(lds, wave_s, g, S, E); }
        }
        SEAM(pb);
        if (IN(pb + 1)) for (int rep_ = 0; rep_ < REP_P2; ++rep_) {
        WS_PTRS();
        PHASE_IDS();
            LAS float* rpbs = (LAS float*)(lds + BIAS_OFF);
            const int g4 = lane >> 4, q = lane & 15, n = wave & 3, rpar = wave >> 2;
            const int kcs = (n == 0) ? 0 : (n == 1) ? 8 : (n == 2) ? 24 : 32;
            const int qc = 16 * n + q, qs = (qc - 8) < 0 ? 0 : ((qc - 8) > 48 ? 48 : (qc - 8));
            bool pooled_inline = false;
            for (int bh = bx; bh < BATCH * NH; bh += G) {
                const int b = bh >> 3, h = bh & 7;
                __syncthreads();
                for (int i = tid; i < 465; i += NTHREADS) rpbs[i] = rpb[((size_t)l * NH + h) * 465 + i] * LOG2E;
                const int kvh = tid >> 8, ctok = (tid & 255) >> 2, c4 = tid & 3, csw = kvh ? (((ctok >> 1) & 3) << 1) : ((ctok >> 1) & 7);
                const unsigned wofs0 = (unsigned)((kvh ? VRING_OFF : KRING_OFF) + ctok * 128 + (((2 * c4) ^ csw) * 16)), wofs1 = (unsigned)((kvh ? VRING_OFF : KRING_OFF) + ctok * 128 + (((2 * c4 + 1) ^ csw) * 16));
                const unsigned char* kvsrc = qkv8 + (size_t)(b * SEQ + ctok) * 1536 + 512 + kvh * 512 + h * 64 + c4 * 16;
#define RING_PUT(SLOT_, W_) do { const u32x4 w__ = (W_); const u32x2 a_ = fp8x4_to_bf16x4(w__[0], 1.0f), b_ = fp8x4_to_bf16x4(w__[1], 1.0f), c_ = fp8x4_to_bf16x4(w__[2], 1.0f), d_ = fp8x4_to_bf16x4(w__[3], 1.0f); \
                    *(LAS u32x4*)(lds + (SLOT_) * 8192 + wofs0) = (u32x4){a_[0], a_[1], b_[0], b_[1]}; *(LAS u32x4*)(lds + (SLOT_) * 8192 + wofs1) = (u32x4){c_[0], c_[1], d_[0], d_[1]}; } while (0)
#pragma unroll
                for (int half = 0; half < 2; ++half) { u32x4 kv[4];
#pragma unroll
                    for (int j = 0; j < 4; ++j) { const int kr = half * 4 + j; kv[j] = __builtin_nontemporal_load((const u32x4*)(kvsrc + (size_t)kr * 64 * 1536)); }
#pragma unroll
                    for (int j = 0; j < 4; ++j) { const int kr = half * 4 + j; RING_PUT(kr, kv[j]); } }
                int hi_loaded = 7, cur_shift = 1000;
                const unsigned char* qbase = qkv8 + (size_t)(b * SEQ + 16 * n + q) * 1536 + h * 64 + 8 * g4;
                u32x2 qn0 = *(const u32x2*)(qbase + (size_t)rpar * 64 * 1536), qn1 = *(const u32x2*)(qbase + (size_t)rpar * 64 * 1536 + 32);
                const int w0 = qs - kcs;
                const bool sel0_0 = (4 * g4 + 0) >= w0, sel0_1 = (4 * g4 + 1) >= w0, sel0_2 = (4 * g4 + 2) >= w0, sel0_3 = (4 * g4 + 3) >= w0;
                const unsigned m01 = (sel0_0 ? 0x0000ffffu : 0u) | (sel0_1 ? 0xffff0000u : 0u), m23 = (sel0_2 ? 0x0000ffffu : 0u) | (sel0_3 ? 0xffff0000u : 0u);
                unsigned bmp[8][2];
#pragma unroll
                for (int i = 0; i < 8; ++i) { bmp[i][0] = 0u; bmp[i][1] = 0u; }
                const int prg = bx * NWAVES + wave; const bool do_pool = (bh == bx) && (prg < T / 32);
                const int phalf = 1 << (lane >> 4), ptb0 = (prg * 32) % SEQ;
                const bf16* pub = proj + (size_t)((prg * 32) / SEQ) * SEQ * DIN + 1536 + lane * 8; unsigned char* pob = mix8 + (size_t)((prg * 32) / SEQ) * SEQ * MIXP + 512 + lane * 16;
                float psum[8];
#pragma unroll
                for (int c = 0; c < 8; ++c) psum[c] = 0.f;
                if (do_pool) { for (int d = -8; d < 8; ++d) { const int j = ptb0 + d; if (d >= -phalf && d < phalf && j >= 0 && j < SEQ) { const u32x4 w = *(const u32x4*)(pub + (size_t)j * DIN);
                        psum[0] += bf_lo(w.x); psum[1] += bf_hi(w.x); psum[2] += bf_lo(w.y); psum[3] += bf_hi(w.y); psum[4] += bf_lo(w.z); psum[5] += bf_hi(w.z); psum[6] += bf_lo(w.w); psum[7] += bf_hi(w.w); } } }
                pooled_inline = pooled_inline || do_pool;
                __syncthreads();
                for (int s = 0; s < 16; ++s) {
                    const int r = 2 * s + rpar;
                    u32x4 pl_[2][3];
#pragma unroll
                    for (int tt = 0; tt < 2; ++tt) { const int t = ptb0 + 2 * s + tt; const int ta = (t + phalf) > SEQ - 1 ? SEQ - 1 : (t + phalf), ts = (t - phalf) < 0 ? 0 : (t - phalf);
                        pl_[tt][0] = *(const u32x4*)(pub + (size_t)t * DIN); pl_[tt][1] = *(const u32x4*)(pub + (size_t)ta * DIN); pl_[tt][2] = *(const u32x4*)(pub + (size_t)ts * DIN); }
                    int next_hi = hi_loaded;
                    if (s < 15) { int rs1 = 2 * s + 3 - 4; rs1 = rs1 < 0 ? 0 : (rs1 > 24 ? 24 : rs1); next_hi = rs1 + 7; }
                    const int nnew = next_hi - hi_loaded;
                    u32x4 pk_[2];
#pragma unroll
                    for (int j = 0; j < 2; ++j) { int kr = hi_loaded + 1 + j; kr = kr > ROWS - 1 ? ROWS - 1 : kr;
                        pk_[j] = __builtin_nontemporal_load((const u32x4*)(kvsrc + (size_t)kr * 64 * 1536)); }
                    int rst = r - 4; rst = rst < 0 ? 0 : (rst > 24 ? 24 : rst);
                    const int shift = rst - r;
                    if (shift != cur_shift) { cur_shift = shift;
#pragma unroll
                        for (int i = 0; i < 8; ++i) { float bv[4];
#pragma unroll
                            for (int e = 0; e < 4; ++e) { const int c = 4 * g4 + e; const int kc = kcs + (c >= w0 ? c : 16 + c);
                                int dc = kc - qc + 15; dc = dc < 0 ? 0 : (dc > 30 ? 30 : dc); const int dr = shift + i + 7;
                                bv[e] = rpbs[dr * 31 + dc]; }
                            bmp[i][0] = cvt_pk_bf16(bv[0], bv[1]); bmp[i][1] = cvt_pk_bf16(bv[2], bv[3]); } }
                    const size_t tq = (size_t)(b * SEQ + r * 64 + 16 * n + q);
                    bf16x8 qf0, qf1;
                    { constexpr float QS = 1.0f / (SC_Q8 * SC_KV8); const u32x2 a0 = fp8x4_to_bf16x4(qn0.x, QS), a1 = fp8x4_to_bf16x4(qn0.y, QS), b0 = fp8x4_to_bf16x4(qn1.x, QS), b1 = fp8x4_to_bf16x4(qn1.y, QS);
                      qf0 = __builtin_bit_cast(bf16x8, (u32x4){a0.x, a0.y, a1.x, a1.y}); qf1 = __builtin_bit_cast(bf16x8, (u32x4){b0.x, b0.y, b1.x, b1.y}); }
                    { const int rn = (r + 2) > ROWS - 1 ? ROWS - 1 : (r + 2); qn0 = *(const u32x2*)(qbase + (size_t)rn * 64 * 1536); qn1 = *(const u32x2*)(qbase + (size_t)rn * 64 * 1536 + 32); }
                    f32x4 sc[8][2];
                    const int slot0 = rst % 9;
#pragma unroll
                    for (int i = 0; i < 8; ++i) { int slot = slot0 + i; slot = slot >= 9 ? slot - 9 : slot;
                        const f32x4 binit = (f32x4){bf_lo(bmp[i][0]), bf_hi(bmp[i][0]), bf_lo(bmp[i][1]), bf_hi(bmp[i][1])};
#pragma unroll
                        for (int jb = 0; jb < 2; ++jb) { const int tok = kcs + 16 * jb + q; const int sw = (tok >> 1) & 7;
                            const LAS unsigned char* kp = lds + KRING_OFF + slot * 8192 + tok * 128;
                            const bf16x8 k0 = *(const LAS bf16x8*)(kp + ((g4 ^ sw) * 16)), k1 = *(const LAS bf16x8*)(kp + (((4 + g4) ^ sw) * 16));
                            f32x4 a = __builtin_amdgcn_mfma_f32_16x16x32_bf16(k0, qf0, binit, 0, 0, 0);
                            sc[i][jb] = __builtin_amdgcn_mfma_f32_16x16x32_bf16(k1, qf1, a, 0, 0, 0); } }
                    float sv[8][4];
#pragma unroll
                    for (int i = 0; i < 8; ++i) { sv[i][0] = sel0_0 ? sc[i][0][0] : sc[i][1][0]; sv[i][1] = sel0_1 ? sc[i][0][1] : sc[i][1][1]; sv[i][2] = sel0_2 ? sc[i][0][2] : sc[i][1][2]; sv[i][3] = sel0_3 ? sc[i][0][3] : sc[i][1][3]; }
                    float mxa = max3f(sv[0][0], sv[0][1], sv[0][2]), mxb = max3f(sv[0][3], sv[1][0], sv[1][1]);
                    mxa = max3f(mxa, sv[1][2], sv[1][3]);
#pragma unroll
                    for (int i = 2; i < 8; ++i) { mxa = max3f(mxa, sv[i][0], sv[i][1]); mxb = max3f(mxb, sv[i][2], sv[i][3]); }
                    float mx = fmaxf(mxa, mxb);
                    mx = fmaxf(mx, __shfl_xor(mx, 16)); mx = fmaxf(mx, __shfl_xor(mx, 32));
                    f32x2 lsum2 = (f32x2){0.f, 0.f}; const f32x2 mx2 = (f32x2){mx, mx}; bf16x8 pf[8];
#pragma unroll
                    for (int i = 0; i < 8; ++i) { const f32x2 d01 = (f32x2){sv[i][0], sv[i][1]} - mx2, d23 = (f32x2){sv[i][2], sv[i][3]} - mx2;
                        f32x2 p01, p23; p01.x = fast_exp2(d01.x); p01.y = fast_exp2(d01.y); p23.x = fast_exp2(d23.x); p23.y = fast_exp2(d23.y);
                        lsum2 += p01 + p23;
                        const unsigned pk01 = cvt_pk_bf16(p01.x, p01.y), pk23 = cvt_pk_bf16(p23.x, p23.y);
                        u32x4 w; w.x = pk01 & m01; w.y = pk23 & m23; w.z = pk01 ^ w.x; w.w = pk23 ^ w.y;
                        pf[i] = __builtin_bit_cast(bf16x8, w); }
                    float lsum = lsum2.x + lsum2.y;
                    lsum += __shfl_xor(lsum, 16); lsum += __shfl_xor(lsum, 32);
                    f32x4 o[4];
#pragma unroll
                    for (int hb = 0; hb < 4; ++hb) o[hb] = (f32x4){0.f, 0.f, 0.f, 0.f};
                    const int qq = q >> 2, pp = lane & 3;
                    const int tokx = kcs + 4 * g4 + qq, toky = tokx + 16;
                    const int swx = ((tokx >> 1) & 3) << 1, swy = ((toky >> 1) & 3) << 1;
#pragma unroll
                    for (int i = 0; i < 8; ++i) { int slot = slot0 + i; slot = slot >= 9 ? slot - 9 : slot;
                        const LAS unsigned char* vbase = lds + VRING_OFF + slot * 8192;
#pragma unroll
                        for (int hb = 0; hb < 4; ++hb) { const int ch = 2 * hb + (pp >> 1);
                            const s16x4 vlo = __builtin_amdgcn_ds_read_tr16_b64_v4i16((LAS s16x4*)(vbase + tokx * 128 + ((ch ^ swx) * 16) + 8 * (pp & 1)));
                            const s16x4 vhi = __builtin_amdgcn_ds_read_tr16_b64_v4i16((LAS s16x4*)(vbase + toky * 128 + ((ch ^ swy) * 16) + 8 * (pp & 1)));
                            const bf16x8 vf = (bf16x8){vlo[0], vlo[1], vlo[2], vlo[3], vhi[0], vhi[1], vhi[2], vhi[3]};
                            o[hb] = __builtin_amdgcn_mfma_f32_16x16x32_bf16(vf, pf[i], o[hb], 0, 0, 0); } }
                    const float rl = 1.0f / (lsum * SC_KV8);
                    unsigned char* op = mix8 + tq * MIXP + h * 64 + 4 * g4; const float rla = rl * SC_A8;
#pragma unroll
                    for (int hb = 0; hb < 4; ++hb) *(unsigned*)(op + 16 * hb) = pk4_fp8(o[hb][0] * rla, o[hb][1] * rla, o[hb][2] * rla, o[hb][3] * rla);
                    if (do_pool) {
#pragma unroll
                        for (int tt = 0; tt < 2; ++tt) { const int t = ptb0 + 2 * s + tt; const int wlo = (t - phalf) < 0 ? 0 : (t - phalf), whi = (t + phalf) > SEQ ? SEQ : (t + phalf);
                            const float rc = 1.0f / (float)(whi - wlo), ma = (t + phalf < SEQ) ? 1.f : 0.f, ms = (t - phalf >= 0) ? -1.f : 0.f;
                            const u32x4 cw = pl_[tt][0], aw = pl_[tt][1], sw_ = pl_[tt][2];
                            const float cv[8] = {bf_lo(cw.x), bf_hi(cw.x), bf_lo(cw.y), bf_hi(cw.y), bf_lo(cw.z), bf_hi(cw.z), bf_lo(cw.w), bf_hi(cw.w)};
                            const float av[8] = {bf_lo(aw.x), bf_hi(aw.x), bf_lo(aw.y), bf_hi(aw.y), bf_lo(aw.z), bf_hi(aw.z), bf_lo(aw.w), bf_hi(aw.w)};
                            const float sv[8] = {bf_lo(sw_.x), bf_hi(sw_.x), bf_lo(sw_.y), bf_hi(sw_.y), bf_lo(sw_.z), bf_hi(sw_.z), bf_lo(sw_.w), bf_hi(sw_.w)};
                            float o_[8];
#pragma unroll
                            for (int c = 0; c < 8; ++c) { o_[c] = psum[c] * rc - cv[c]; psum[c] += ma * av[c] + ms * sv[c]; }
                            u32x4 w; w.x = cvt_pk_bf16(o_[0], o_[1]); w.y = cvt_pk_bf16(o_[2], o_[3]); w.z = cvt_pk_bf16(o_[4], o_[5]); w.w = cvt_pk_bf16(o_[6], o_[7]);
                            *(u32x4*)(pob + (size_t)t * MIXP) = w; } }
                    __syncthreads();
#pragma unroll
                    for (int j = 0; j < 2; ++j) if (j < nnew) { const int kr = hi_loaded + 1 + j; const int sl = kr % 9; RING_PUT(sl, pk_[j]); }
                    hi_loaded = next_hi;
                    __syncthreads();
                }
            }
            {
                const int half = 1 << (lane >> 4);
                for (int rg = bx * NWAVES + wave + (pooled_inline ? G * NWAVES : 0); rg < T / 32; rg += G * NWAVES) {
                    const int t0 = rg * 32, bb = t0 / SEQ, tb0 = t0 % SEQ;
                    const bf16* ub = proj + (size_t)bb * SEQ * DIN + 1536 + lane * 8;
                    unsigned char* ob = mix8 + (size_t)bb * SEQ * MIXP + 512 + lane * 16;
                    float sum[8];
#pragma unroll
                    for (int c = 0; c < 8; ++c) sum[c] = 0.f;
                    for (int d = -8; d < 8; ++d) { const int j = tb0 + d; if (d >= -half && d < half && j >= 0 && j < SEQ) { const u32x4 w = *(const u32x4*)(ub + (size_t)j * DIN);
                            sum[0] += bf_lo(w.x); sum[1] += bf_hi(w.x); sum[2] += bf_lo(w.y); sum[3] += bf_hi(w.y); sum[4] += bf_lo(w.z); sum[5] += bf_hi(w.z); sum[6] += bf_lo(w.w); sum[7] += bf_hi(w.w); } }
#pragma unroll 4
                    for (int tt = 0; tt < 32; ++tt) { const int t = tb0 + tt; const int wlo = (t - half) < 0 ? 0 : (t - half), whi = (t + half) > SEQ ? SEQ : (t + half);
                        const float rc = 1.0f / (float)(whi - wlo);
                        const u32x4 cw = *(const u32x4*)(ub + (size_t)t * DIN);
                        float o_[8]; const float cv[8] = {bf_lo(cw.x), bf_hi(cw.x), bf_lo(cw.y), bf_hi(cw.y), bf_lo(cw.z), bf_hi(cw.z), bf_lo(cw.w), bf_hi(cw.w)};
#pragma unroll
                        for (int c = 0; c < 8; ++c) o_[c] = sum[c] * rc - cv[c];
                        u32x4 w; w.x = cvt_pk_bf16(o_[0], o_[1]); w.y = cvt_pk_bf16(o_[2], o_[3]); w.z = cvt_pk_bf16(o_[4], o_[5]); w.w = cvt_pk_bf16(o_[6], o_[7]);
                        *(u32x4*)(ob + (size_t)t * MIXP) = w;
                        if (t + half < SEQ) { const u32x4 a = *(const u32x4*)(ub + (size_t)(t + half) * DIN);
                            sum[0] += bf_lo(a.x); sum[1] += bf_hi(a.x); sum[2] += bf_lo(a.y); sum[3] += bf_hi(a.y); sum[4] += bf_lo(a.z); sum[5] += bf_hi(a.z); sum[6] += bf_lo(a.w); sum[7] += bf_hi(a.w); }
                        if (t - half >= 0) { const u32x4 a = *(const u32x4*)(ub + (size_t)(t - half) * DIN);
                            sum[0] -= bf_lo(a.x); sum[1] -= bf_hi(a.x); sum[2] -= bf_lo(a.y); sum[3] -= bf_hi(a.y); sum[4] -= bf_lo(a.z); sum[5] -= bf_hi(a.z); sum[6] -= bf_lo(a.w); sum[7] -= bf_hi(a.w); }
                    }
                }
            }
            __syncthreads();
        }
        SEAM(pb + 1);
        if (IN(pb + 2)) for (int rep_ = 0; rep_ < (l == 0 ? REP_P3L0 : 1); ++rep_) {
        WS_PTRS();
            pg8::Gemm g{MIXP / 2, MIXP / 2, MIXP / 2, 1 << 20, (unsigned)(128 * MIXP), nullptr, 4};
            pg8::StaticOrder S; S.init(mix8, Wout8 + (size_t)l * D * MIXP, MIXP / 2, MIXP / 2, T, D, G, opaque_s(bx), 1);
            pg8::EpiRes E{xb, x8};
            pg8::gemm_phase<pg8::EpiRes, pg8::StaticOrder, false, 2, false, 2>(lds, wave_s, g, S, E);
        }
        SEAM(pb + 2);
        if (IN(pb + 3)) {
        WS_PTRS();
        PHASE_IDS();
            volatile LAS int* cntl = (volatile LAS int*)(MISC + MW_CNTL); volatile LAS int* basel = (volatile LAS int*)(MISC + MW_BASEL);
            { const u32x4* src = rfrag + (size_t)l * 8192; for (int i = tid; i < 8192; i += NTHREADS) ((LAS u32x4*)lds)[i] = src[i]; }
            gu32* gcnt = ctl + CW_CNT + 32 * l;
            for (int it = 0;; ++it) {
                const int tile0 = (it * G + bx) * NWAVES; if (tile0 >= T / 32) break;
                if (tid < NBUCKET) cntl[tid] = 0;
                __syncthreads();
                const int tile = tile0 + wave, tokn = tile * 32 + (lane & 31), kg = lane >> 5;
                const u32x4* xr = (const u32x4*)(xb + (size_t)tokn * D + kg * 32);
                f32x16 acc;
#pragma unroll
                for (int i = 0; i < 16; ++i) acc[i] = 0.f;
                float ss = 0.f;
#pragma unroll 4
                for (int G4 = 0; G4 < 16; ++G4) { u32x4 v[4];
#pragma unroll
                    for (int j = 0; j < 4; ++j) v[j] = xr[G4 * 8 + j];
#pragma unroll
                    for (int s4 = 0; s4 < 4; ++s4) { const u32x4 hw = v[s4];
                        const float f0 = bf_lo(hw.x), f1 = bf_hi(hw.x), f2 = bf_lo(hw.y), f3 = bf_hi(hw.y), f4 = bf_lo(hw.z), f5 = bf_hi(hw.z), f6 = bf_lo(hw.w), f7 = bf_hi(hw.w);
                        ss += ((f0 * f0 + f1 * f1) + (f2 * f2 + f3 * f3)) + ((f4 * f4 + f5 * f5) + (f6 * f6 + f7 * f7));
                        const int step = G4 * 4 + s4;
                        const bf16x8 ah = *(const LAS bf16x8*)(lds + ((0 * 64 + step) * 64 + lane) * 16), al = *(const LAS bf16x8*)(lds + ((1 * 64 + step) * 64 + lane) * 16);
                        const bf16x8 bh_ = __builtin_bit_cast(bf16x8, hw);
                        acc = __builtin_amdgcn_mfma_f32_32x32x16_bf16(ah, bh_, acc, 0, 0, 0);
                        acc = __builtin_amdgcn_mfma_f32_32x32x16_bf16(al, bh_, acc, 0, 0, 0); } }
                ss += __shfl_xor(ss, 32);
                const float rs = __builtin_amdgcn_rsqf(ss * (1.0f / D) + EPS);
                const float g0 = acc[0] * rs, g1 = acc[1] * rs, g2 = acc[2] * rs, g3 = acc[3] * rs;
                int gi = 0; float gb = g0; if (g1 > gb) { gb = g1; gi = 1; } if (g2 > gb) { gb = g2; gi = 2; } if (g3 > gb) { gb = g3; gi = 3; }
                const float gsum = fast_exp2((g0 - gb) * LOG2E) + fast_exp2((g1 - gb) * LOG2E) + fast_exp2((g2 - gb) * LOG2E) + fast_exp2((g3 - gb) * LOG2E);
                const float gwt = 1.0f / gsum;
                const bool hiq = (gi >> 1) != 0;
                const float e0 = (hiq ? acc[8] : acc[4]) * rs, e1 = (hiq ? acc[9] : acc[5]) * rs, e2 = (hiq ? acc[10] : acc[6]) * rs, e3 = (hiq ? acc[11] : acc[7]) * rs;
                int i1 = 0; float v1 = e0; if (e1 > v1) { v1 = e1; i1 = 1; } if (e2 > v1) { v1 = e2; i1 = 2; } if (e3 > v1) { v1 = e3; i1 = 3; }
                int i2 = (i1 == 0) ? 1 : 0; float v2 = (i1 == 0) ? e1 : e0;
                if (i1 != 1 && i2 != 1 && e1 > v2) { v2 = e1; i2 = 1; }
                if (i1 != 2 && e2 > v2) { v2 = e2; i2 = 2; }
                if (i1 != 3 && e3 > v2) { v2 = e3; i2 = 3; }
                const float w1 = gwt / (1.0f + fast_exp2((v2 - v1) * LOG2E)), w2 = gwt - w1;
                const int ea = i1 < i2 ? i1 : i2, eb = i1 < i2 ? i2 : i1; const float wa = i1 < i2 ? w1 : w2, wb = i1 < i2 ? w2 : w1;
                const int bucket = gi * 6 + (ea == 0 ? 0 : (ea == 1 ? 3 : 5)) + (eb - ea - 1);
                const bool owner = (kg == (gi & 1));
                int rank = 0;
                if (owner) rank = __hip_atomic_fetch_add((LAS int*)(MISC + MW_CNTL) + bucket, 1, __ATOMIC_RELAXED, __HIP_MEMORY_SCOPE_WORKGROUP);
                __syncthreads();
                if (tid < NBUCKET) { const int c = cntl[tid]; basel[tid] = c ? (int)__hip_atomic_fetch_add(gcnt + tid, (unsigned)c, RLX_AGENT) : 0; }
                __syncthreads();
                if (owner) { u32x4 e; e.x = (unsigned)tokn; e.y = __float_as_uint(rs * (1.0f / (SC_X8 * SC_WGU))); e.z = __float_as_uint(wa * SC_H8); e.w = __float_as_uint(wb * SC_H8);
                    list[(size_t)bucket * T + basel[bucket] + rank] = e; }
            }
            __syncthreads();
        }
        SEAM(pb + 3);
        if (IN(pb + 4) || IN(pb + 5)) {
        PHASE_IDS();
            volatile LAS int* tb = (volatile LAS int*)(MISC + MW_TB); volatile LAS int* cnt2 = (volatile LAS int*)(MISC + MW_CNT2);
            __syncthreads();
            if (tid == 0) { int a = 0;
#pragma nounroll
                for (int k = 0; k < NBUCKET; ++k) { const int c = (int)__hip_atomic_load(ctl + CW_CNT + 32 * l + k, RLX_AGENT); cnt2[k] = c; tb[k] = a; a += (c + 255) >> 8; } tb[NBUCKET] = a; }
            __syncthreads();
        }
        if (IN(pb + 4)) for (int rep_ = 0; rep_ < REP_P5; ++rep_) {
        WS_PTRS();
            const volatile LAS int* tb = (const volatile LAS int*)(MISC + MW_TB);
            pg8::Gemm g{D / 2, D / 2, D / 2, 1 << 20, (unsigned)(512 * D), nullptr};
            MoeOrder<8> S{tb, (const volatile LAS int*)(MISC + MW_CNT2), tb[NBUCKET] * 8, G, opaque_s(vcu), (const char*)x8, (const char*)(Wgu8 + (size_t)l * NE * 1024 * D), list};
            pg8::EpiSwiglu E{H8};
            pg8::gemm_phase<pg8::EpiSwiglu, MoeOrder<8>, true, 1, false, true>(lds, wave_s, g, S, E);
            if (l + 1 < DEPTH) {
                const int rem = S.nunits % G;
                if (rem != 0 && S.c >= rem) { PHASE_IDS(); LAS float* scr = (LAS float*)(lds + wave * 16384);
                    const int gwx = (S.c - rem) * NWAVES + wave, ngwx = (G - rem) * NWAVES;
                    CONVERT_WEIGHTS(4 * (l + 1), 4 * (l + 1) + 2, gwx, ngwx) } }
        }
        SEAM(pb + 4);
        if (IN(pb + 5)) {
        WS_PTRS();
            const volatile LAS int* tb = (const volatile LAS int*)(MISC + MW_TB);
            pg8::Gemm g{D / 2, DE / 2, D / 2, 4, (unsigned)(128 * DE), nullptr};
            MoeOrder<4> S{tb, (const volatile LAS int*)(MISC + MW_CNT2), tb[NBUCKET] * 4, G, opaque_s(vcu), (const char*)H8, (const char*)(Wd8 + (size_t)l * NE * 1024 * DE), list};
            pg8::EpiScatter E{xb, ssq, x8};
            pg8::gemm_phase<pg8::EpiScatter, MoeOrder<4>, true, 2, true, true>(lds, wave_s, g, S, E);
            if (l + 1 < DEPTH) {
                const int rem = S.nunits % G; const bool slack = rem != 0 && S.c >= rem;
                const int q0 = ((tb[NBUCKET] * 8) % G) != 0 ? 2 : 0;
                if (rem == 0 || slack) { PHASE_IDS(); LAS float* scr = (LAS float*)(lds + wave * 16384);
                    const int gwx = (rem == 0 ? S.c : S.c - rem) * NWAVES + wave, ngwx = (rem == 0 ? G : G - rem) * NWAVES;
                    CONVERT_WEIGHTS(4 * (l + 1) + q0, 4 * (l + 1) + 4, gwx, ngwx) } }
        }
        SEAM(pb + 5);
    }
    if (IN(N_PHASES - 1)) {
        PHASE_IDS();
        WS_PTRS();
        const f32x4* gp8 = (const f32x4*)final_g;
        for (int m0 = gw * 4; m0 < T; m0 += NGW * 4) {
            u32x4 v[4][2];
#pragma unroll
            for (int rr = 0; rr < 4; ++rr)
#pragma unroll
                for (int j = 0; j < 2; ++j) v[rr][j] = ((const u32x4*)(xb + (size_t)(m0 + rr) * D))[lane + 64 * j];
#pragma unroll
            for (int rr = 0; rr < 4; ++rr) { float f[2][8]; float s = 0.f;
#pragma unroll
                for (int j = 0; j < 2; ++j) { const u32x4 w = v[rr][j]; f[j][0] = bf_lo(w.x); f[j][1] = bf_hi(w.x); f[j][2] = bf_lo(w.y); f[j][3] = bf_hi(w.y); f[j][4] = bf_lo(w.z); f[j][5] = bf_hi(w.z); f[j][6] = bf_lo(w.w); f[j][7] = bf_hi(w.w);
#pragma unroll
                    for (int c = 0; c < 8; ++c) s += f[j][c] * f[j][c]; }
                s = wave_sum(s); const float rs = 1.0f / sqrtf(s * (1.0f / D) + EPS);
                float* orow = args.out + (size_t)(m0 + rr) * D;
#pragma unroll
                for (int j = 0; j < 2; ++j) { const f32x4 ga = gp8[(lane + 64 * j) * 2], gb = gp8[(lane + 64 * j) * 2 + 1];
                    *(f32x4*)(orow + 8 * (lane + 64 * j)) = (f32x4){f[j][0], f[j][1], f[j][2], f[j][3]} * rs * ga;
                    *(f32x4*)(orow + 8 * (lane + 64 * j) + 4) = (f32x4){f[j][4], f[j][5], f[j][6], f[j][7]} * rs * gb; } }
        }
    }
#undef IN
#undef SEAM
#undef PHASE_IDS
#undef RING_PUT
#undef WS_PTRS
}

extern "C" void kernel_launch(void* const* d_in, const int* in_sizes, int n_in, void* d_out, int out_size, void* d_ws, size_t ws_size, hipStream_t stream) {
    static int grid = 0;
    if (grid == 0) {
        if (n_in != 14 || in_sizes[0] != T * D || out_size != T * D || ws_size < WS_END) { fprintf(stderr, "kernel_launch: unexpected shapes / workspace (n_in %d, ws %zu)\n", n_in, ws_size); grid = -1; return; }
        int dev = 0, cus = 0, per_cu = 0;
        if (hipGetDevice(&dev) != hipSuccess || hipDeviceGetAttribute(&cus, hipDeviceAttributeMultiprocessorCount, dev) != hipSuccess) { grid = -1; return; }
        if (hipFuncSetAttribute((const void*)enc_fwd, hipFuncAttributeMaxDynamicSharedMemorySize, LDS_BYTES) != hipSuccess) { fprintf(stderr, "kernel_launch: hipFuncSetAttribute failed\n"); grid = -1; return; }
        if (hipOccupancyMaxActiveBlocksPerMultiprocessor(&per_cu, (const void*)enc_fwd, NTHREADS, LDS_BYTES) != hipSuccess || per_cu < 1) { fprintf(stderr, "kernel_launch: occupancy query reports %d\n", per_cu); }
        (void)hipGetLastError();
        grid = cus;
    }
    if (grid < 0) return;
    (void)hipMemsetAsync((char*)d_ws + WS_CTL, 0, CTL_ZERO_BYTES, stream);
    Args a{};
    for (int i = 0; i < 14; ++i) a.in[i] = (const float*)d_in[i];
    a.out = (float*)d_out; a.ws = (unsigned char*)d_ws; a.pad = 0;
    if (MK_N_LAUNCHES == 1) {
        a.ph_lo = 0; a.ph_hi = N_PHASES; a.li = 0;
        hipLaunchKernelGGL(enc_fwd, dim3(grid), dim3(NTHREADS), LDS_BYTES, stream, a);
    } else {
        for (int p = 0; p < N_PHASES; ++p) { a.ph_lo = p; a.ph_hi = p + 1; a.li = p; hipLaunchKernelGGL(enc_fwd, dim3(grid), dim3(NTHREADS), LDS_BYTES, stream, a); }
    }
}
```

```cpp
#include <hip/hip_runtime.h>
#include <cstdio>
#include <cstdint>

#define REP_P0 1
#define REP_P1 1
#define REP_P2 1
#define REP_P3L0 1
#define REP_P5 1
#ifndef MK_N_LAUNCHES
#define MK_N_LAUNCHES 1
#endif

#define GAS __attribute__((address_space(1)))
#define LAS __attribute__((address_space(3)))
typedef unsigned short bf16;
typedef short bf16x8 __attribute__((ext_vector_type(8)));
typedef short s16x4 __attribute__((ext_vector_type(4)));
typedef float f32x4 __attribute__((ext_vector_type(4)));
typedef float f32x2 __attribute__((ext_vector_type(2)));
typedef float f32x16 __attribute__((ext_vector_type(16)));
typedef unsigned u32x4 __attribute__((ext_vector_type(4)));
typedef unsigned u32x2 __attribute__((ext_vector_type(2)));
typedef GAS unsigned gu32;

constexpr int D = 1024, BATCH = 32, SEQ = 2048, T = BATCH * SEQ, DEPTH = 4;
constexpr int DIN = 2048, NH = 8, HD = 64, GRIDW = 64, ROWS = SEQ / GRIDW;
constexpr int NE = 16, DE = 512, NBUCKET = 24;
constexpr float EPS = 1e-6f, LOG2E = 1.4426950408889634f;
constexpr int NWAVES = 8, NTHREADS = 512;

constexpr size_t MiB = 1u << 20;
constexpr size_t WS_CTL = 0, CTL_ZERO_BYTES = 1 * MiB;
constexpr size_t WS_WIN = 2 * MiB;
constexpr size_t WS_WOUT = 18 * MiB;
constexpr size_t WS_WGU = 26 * MiB;
constexpr size_t WS_WD = 154 * MiB;
constexpr size_t WS_RFRAG = 218 * MiB;
constexpr size_t WS_SSQ = 219 * MiB;
constexpr size_t WS_LIST = 223 * MiB;
constexpr size_t WS_XB = 248 * MiB;
constexpr size_t WS_PROJ = 376 * MiB;
constexpr size_t WS_H = WS_PROJ;
constexpr size_t WS_MIX = 632 * MiB;
constexpr size_t WS_X8 = 760 * MiB;
constexpr size_t WS_WIN8 = 824 * MiB;
constexpr size_t WS_QKV8 = 832 * MiB;
constexpr size_t WS_END = 928 * MiB;
constexpr float SC_Q8 = 16.0f, SC_KV8 = 4.0f, SC_A8 = 16.0f;
constexpr int MIXP = 1536;
constexpr float SC_X8 = 4.0f, SC_WGU = 64.0f, SC_H8 = 16.0f, SC_WD = 128.0f;
constexpr int MAXTILES = T / 256 + NBUCKET;
static_assert((size_t)MAXTILES * 256 * 1024 * 2 <= 256 * MiB, "H fits the proj overlay");
constexpr int CW_TMO = 0, CW_CODE = 1, CW_BAR = 4096, CW_CNT = 8192;

constexpr int RING_BYTES = 131072;
constexpr int KRING_OFF = 0, VRING_OFF = 73728, ATT_RING_END = 147456;
constexpr int BIAS_OFF = ATT_RING_END;
constexpr int MISC_OFF = BIAS_OFF + 2048;
constexpr int LDS_BYTES = MISC_OFF + 512;
constexpr int MW_BAR = 0, MW_CNTL = 4, MW_BASEL = 32, MW_TB = 64, MW_CNT2 = 96;

#define RLX_AGENT __ATOMIC_RELAXED, __HIP_MEMORY_SCOPE_AGENT
#define LDS_WAIT() asm volatile("s_waitcnt lgkmcnt(0)" ::: "memory")
#define VM_WAIT() asm volatile("s_waitcnt vmcnt(0)" ::: "memory")
__device__ __forceinline__ unsigned f2bf(float f) { unsigned u = __builtin_bit_cast(unsigned, f); return (u + 0x7fffu + ((u >> 16) & 1u)) >> 16; }
__device__ __forceinline__ unsigned pk2(float lo, float hi) { return f2bf(lo) | (f2bf(hi) << 16); }
__device__ __forceinline__ unsigned cvt_pk_bf16(float lo, float hi) { unsigned r; asm volatile("v_cvt_pk_bf16_f32 %0, %1, %2" : "=v"(r) : "v"(lo), "v"(hi)); return r; }
__device__ __forceinline__ float bf_lo(unsigned w) { return __builtin_bit_cast(float, w << 16); }
__device__ __forceinline__ float bf_hi(unsigned w) { return __builtin_bit_cast(float, w & 0xffff0000u); }
__device__ __forceinline__ int lane_id() { int r; asm volatile("v_mbcnt_lo_u32_b32 %0, -1, 0\n\tv_mbcnt_hi_u32_b32 %0, -1, %0" : "=v"(r)); return r; }
template <class P> __device__ __forceinline__ P* opaque_p(P* p) { asm volatile("" : "+s"(p)); return p; }
__device__ __forceinline__ int opaque_s(int v) { asm volatile("" : "+s"(v)); return v; }
__device__ __forceinline__ int opaque(int v) { asm volatile("" : "+v"(v)); return v; }
__device__ __forceinline__ unsigned pk4_fp8(float a, float b, float c, float d) {
    int w = 0; w = __builtin_amdgcn_cvt_pk_fp8_f32(a, b, w, false); w = __builtin_amdgcn_cvt_pk_fp8_f32(c, d, w, true); return (unsigned)w; }
typedef float f32x2v __attribute__((ext_vector_type(2)));
__device__ __forceinline__ u32x2 fp8x4_to_bf16x4(unsigned w, float s) {
    const f32x2v a = __builtin_amdgcn_cvt_pk_f32_fp8((int)w, false), b = __builtin_amdgcn_cvt_pk_f32_fp8((int)w, true);
    u32x2 r; r.x = cvt_pk_bf16(a[0] * s, a[1] * s); r.y = cvt_pk_bf16(b[0] * s, b[1] * s); return r; }
__device__ __forceinline__ float max3f(float a, float b, float c) { float r; asm("v_max3_f32 %0, %1, %2, %3" : "=v"(r) : "v"(a), "v"(b), "v"(c)); return r; }
__device__ __forceinline__ float fast_exp2(float x) { return __builtin_amdgcn_exp2f(x); }
__device__ __forceinline__ float fast_rcp(float x) { return __builtin_amdgcn_rcpf(x); }

#define XB_TMO      128
#define XB_XCNT(j)  (256  + 64 * (j))
#define XB_XSUB(j)  (1280 + 64 * (j))
#define XB_XGEN(j)  (2304 + 64 * (j))
#define XB_TOP      3328
#define XB_TOPGEN   3392
#define XCD_BAR_WORDS 3456
#define XB_SPIN_CAP (1u << 22)
__device__ __forceinline__ unsigned xb_ld(unsigned* p)              { return __hip_atomic_load(p, __ATOMIC_RELAXED, __HIP_MEMORY_SCOPE_AGENT); }
__device__ __forceinline__ unsigned xb_add(unsigned* p, unsigned v) { return __hip_atomic_fetch_add(p, v, __ATOMIC_RELAXED, __HIP_MEMORY_SCOPE_AGENT); }
__device__ __forceinline__ unsigned xb_xcc_id() { return (unsigned)__builtin_amdgcn_s_getreg((3 << 11) | 20) & 0xFu; }
#define XB_SPIN(cond, bar) do { unsigned _sp = 0; while (cond) { __builtin_amdgcn_s_sleep(1); \
    if ((++_sp & 255u) == 0u) { if (xb_ld(&(bar)[XB_TMO])) break; if (_sp > XB_SPIN_CAP) { atomicAdd(&(bar)[XB_TMO], 1u); break; } } } } while (0)
struct XcdBarrier { unsigned* bar; unsigned x; volatile LAS unsigned* st; };
__device__ __forceinline__ XcdBarrier xcd_barrier_post(unsigned* bar, volatile LAS unsigned* st) {
    XcdBarrier b; b.bar = bar; b.x = xb_xcc_id(); b.st = st;
    if (threadIdx.x == 0) (void)xb_add(&bar[XB_XCNT(b.x)], 1u);
    return b;
}
__device__ __forceinline__ void xcd_barrier_complete(unsigned* bar, unsigned x, unsigned& nloc, unsigned& nx) {
    const unsigned G = gridDim.x * gridDim.y * gridDim.z;
    unsigned sum, cnt, mine, sp = 0u;
    for (;;) {
        sum = 0u; cnt = 0u; mine = 0u;
#pragma nounroll
        for (unsigned j = 0; j < 16; ++j) { const unsigned c = xb_ld(&bar[XB_XCNT(j)]); sum += c; cnt += (c > 0u) ? 1u : 0u; mine = (j == x) ? c : mine; }
        if (sum == G) break;
        __builtin_amdgcn_s_sleep(1);
        if ((++sp & 255u) == 0u) { if (xb_ld(&bar[XB_TMO])) break; if (sp > XB_SPIN_CAP) { atomicAdd(&bar[XB_TMO], 1u); break; } }
    }
    nloc = mine > 0u ? mine : 1u; nx = cnt > 0u ? cnt : 1u;
}
__device__ __forceinline__ void xcd_barrier(const XcdBarrier& b, const bool leader) {
    asm volatile("s_waitcnt vmcnt(0)" ::: "memory");
    __syncthreads();
    if (leader) {
        unsigned* bar = b.bar;
        __builtin_amdgcn_s_waitcnt(0);
        unsigned nloc = b.st[0], nx = b.st[1];
        if (nloc == 0u) { xcd_barrier_complete(bar, b.x, nloc, nx); b.st[0] = nloc; b.st[1] = nx; }
        const unsigned old = xb_add(&bar[XB_XSUB(b.x)], 1u);
        const unsigned gen = old / nloc;
        if (old + 1u == (gen + 1u) * nloc) {
            __builtin_amdgcn_fence(__ATOMIC_RELEASE, "agent");
            asm volatile("s_waitcnt vmcnt(0)" ::: "memory");
            const unsigned og = xb_add(&bar[XB_TOP], 1u);
            const unsigned tg = og / nx;
            if (og + 1u == (tg + 1u) * nx) xb_add(&bar[XB_TOPGEN], 1u);
            else XB_SPIN(xb_ld(&bar[XB_TOPGEN]) == tg, bar);
            __builtin_amdgcn_fence(__ATOMIC_ACQUIRE, "agent");
            xb_add(&bar[XB_XGEN(b.x)], 1u);
            asm volatile("s_waitcnt vmcnt(0)" ::: "memory");
        } else {
            XB_SPIN(xb_ld(&bar[XB_XGEN(b.x)]) == gen, bar);
            __builtin_amdgcn_fence(__ATOMIC_ACQUIRE, "agent");
            asm volatile("s_waitcnt vmcnt(0)" ::: "memory");
        }
    }
    __syncthreads();
}

__device__ __forceinline__ void glds16(const char* sbase, unsigned voff, unsigned lds_dst) { unsigned keep;
    asm volatile("s_mov_b32 %0, m0\n\ts_mov_b32 m0, %3\n\ts_nop 0\n\tglobal_load_lds_dwordx4 %1, %2\n\ts_mov_b32 m0, %0" : "=&s"(keep) : "v"(voff), "s"(sbase), "s"(lds_dst) : "memory"); }

namespace pg8 {
constexpr int BM = 256, BK = 64, HALF = 128, HTB = HALF * BK * 2, STAGE_BYTES = 8 * HTB, NXCD = 8, WGM = 8;
__host__ __device__ __forceinline__ int lds_byte(int r, int c) { const int st = (r >> 4) * 2 + (c >> 5), rr = r & 15, cc = c & 31, ob = rr * 64 + cc * 2; return st * 1024 + (ob ^ (((ob >> 9) & 1) << 5)); }
__host__ __device__ __forceinline__ void stage_rc(int b, int& R, int& C) { const int st = b / 1024, sb = b % 1024, swz = sb ^ (((sb >> 9) & 1) << 5); R = (st >> 1) * 16 + swz / 64; C = (st & 1) * 32 + (swz % 64) / 2; }
__host__ __device__ __forceinline__ int perm32(int rho) { const int n = rho >> 4, i = rho & 15; return 8 * (i >> 2) + 4 * n + (i & 3); }

struct Unit {
    const char* A;
    const char* B;
    const char* B2;
    const u32x4* rows;
    int nvalid, pm, pn, tile, sub;
};
struct Gemm { int lda, ldb, K, ksplit; unsigned hstepB; const char* aux; int mixk; };

struct StaticOrder {
    const char* A; const char* Bt; int lda, ldb;
    int nM, nN, nwg, G, c, abase;
    __device__ void init(const void* A_, const void* Bt_, int lda_, int ldb_, int M, int N, int G_, int c_, int abase_) { A = (const char*)A_; Bt = (const char*)Bt_; lda = lda_; ldb = ldb_; nM = M / BM; nN = N / BM; nwg = nM * nN; G = G_; c = c_; abase = abase_; }
    __device__ bool next(int i, Unit& u) const {
        const int L = i * G + c; if (L >= nwg) return false;
        int wgid = L; { const int q = nwg / NXCD, r = nwg % NXCD, xcd = wgid % NXCD, off = wgid / NXCD; wgid = (xcd < r ? xcd * (q + 1) : r * (q + 1) + (xcd - r) * q) + off; }
        const int nig = WGM * nN, gid = wgid / nig, fm = gid * WGM, gsz = (nM - fm) < WGM ? (nM - fm) : WGM;
        u.pm = fm + ((wgid % nig) % gsz); u.pn = (wgid % nig) / gsz;
        u.A = abase ? A : A + (size_t)u.pm * BM * lda * 2; u.B = Bt + (size_t)u.pn * BM * ldb * 2; u.B2 = u.B; u.rows = nullptr; u.nvalid = BM; u.tile = u.pm; u.sub = u.pn;
        return true;
    }
};

constexpr int ETAB_OFF = 131072, ETAB_BYTES = 4096;
typedef int i32x8 __attribute__((ext_vector_type(8)));
typedef int i32x4v __attribute__((ext_vector_type(4)));
template <class Epi, class Sched, bool ETAB, int GATHER, bool SPLITK, int FP8, bool SSQP = false>
__device__ __forceinline__ void gemm_phase(LAS unsigned char* lds, const int wid_in, const Gemm g, const Sched& S, const Epi& E) {
    const int wid = opaque_s(wid_in);
    const int lane = lane_id(), tid = wid * 64 + lane, wr = wid >> 2, wc = wid & 3, fr = lane & 15, fq = lane >> 4;
    const int nt = opaque_s(g.K / BK);
    unsigned cvA[2][2], voffB[2];
#pragma unroll
    for (int i = 0; i < 2; ++i) { int R, C; stage_rc(tid * 16 + i * 8192, R, C); const int Rb = Epi::PERM ? ((R & ~31) + perm32(R & 31)) : R;
        voffB[i] = (unsigned)(Rb * g.ldb + C) * 2u;
#pragma unroll
        for (int h = 0; h < 2; ++h) cvA[h][i] = (unsigned)((R + h * HALF) * g.lda + C) * 2u; }
    const size_t kstep = (size_t)(BK * 2);
    const size_t hstepB = g.hstepB;
    const unsigned ldsw = (unsigned)wid * 1024u, ldsb = (unsigned)(size_t)lds;
    const int aoff = lds_byte(wr * 64 + fr, fq * 8), boff = lds_byte(wc * 32 + fr, fq * 8);
#define PG8_SA(b, h) (((b) * 2 + (h)) * HTB)
#define PG8_SB(b, h) ((4 + (b) * 2 + (h)) * HTB)
#define PG8_STAGE(bufoff, gbase, v0, v1) do { glds16((const char*)(gbase), (v0), ldsb + (unsigned)(bufoff) + ldsw); glds16((const char*)(gbase), (v1), ldsb + (unsigned)(bufoff) + ldsw + 8192u); } while (0)
#define PG8_LD16(off) (*(const LAS i32x4v*)(lds + (off)))
#define PG8_LDA(dst, b, h) do { if constexpr (FP8 != 0) { _Pragma("unroll") for (int m = 0; m < 4; ++m) dst##8[m] = __builtin_shufflevector(PG8_LD16(PG8_SA(b, h) + aoff + m * 2048), PG8_LD16(PG8_SA(b, h) + aoff + m * 2048 + 1024), 0, 1, 2, 3, 4, 5, 6, 7); } \
        else { _Pragma("unroll") for (int m = 0; m < 4; ++m) _Pragma("unroll") for (int k = 0; k < 2; ++k) dst[m][k] = *(const LAS bf16x8*)(lds + PG8_SA(b, h) + aoff + m * 2048 + k * 1024); } } while (0)
#define PG8_LDB(dst, b, h) do { if constexpr (FP8 != 0) { _Pragma("unroll") for (int n = 0; n < 2; ++n) dst##8[n] = __builtin_shufflevector(PG8_LD16(PG8_SB(b, h) + boff + n * 2048), PG8_LD16(PG8_SB(b, h) + boff + n * 2048 + 1024), 0, 1, 2, 3, 4, 5, 6, 7); } \
        else { _Pragma("unroll") for (int n = 0; n < 2; ++n) _Pragma("unroll") for (int k = 0; k < 2; ++k) dst[n][k] = *(const LAS bf16x8*)(lds + PG8_SB(b, h) + boff + n * 2048 + k * 1024); } } while (0)
#define PG8_H0(x) __builtin_bit_cast(bf16x8, __builtin_shufflevector(x, x, 0, 1, 2, 3))
#define PG8_H1(x) __builtin_bit_cast(bf16x8, __builtin_shufflevector(x, x, 4, 5, 6, 7))
#define PG8_MMA(ai, bj, At, Bt, F8_) do { __builtin_amdgcn_s_setprio(1); \
        if constexpr ((F8_) == 1) { _Pragma("unroll") for (int m = 0; m < 4; ++m) _Pragma("unroll") for (int n = 0; n < 2; ++n) \
            acc[ai][bj][m][n] = __builtin_amdgcn_mfma_scale_f32_16x16x128_f8f6f4(Bt##8[n], At##8[m], acc[ai][bj][m][n], 0, 0, 0, 0, 0, 0); } \
        else if constexpr (FP8 != 0) { _Pragma("unroll") for (int m = 0; m < 4; ++m) _Pragma("unroll") for (int n = 0; n < 2; ++n) { \
            acc[ai][bj][m][n] = __builtin_amdgcn_mfma_f32_16x16x32_bf16(PG8_H0(Bt##8[n]), PG8_H0(At##8[m]), acc[ai][bj][m][n], 0, 0, 0); \
            acc[ai][bj][m][n] = __builtin_amdgcn_mfma_f32_16x16x32_bf16(PG8_H1(Bt##8[n]), PG8_H1(At##8[m]), acc[ai][bj][m][n], 0, 0, 0); } } \
        else { _Pragma("unroll") for (int m = 0; m < 4; ++m) _Pragma("unroll") for (int n = 0; n < 2; ++n) _Pragma("unroll") for (int k = 0; k < 2; ++k) \
            acc[ai][bj][m][n] = __builtin_amdgcn_mfma_f32_16x16x32_bf16(Bt[n % (FP8 != 0 ? 1 : 2)][k], At[m % (FP8 != 0 ? 1 : 4)][k], acc[ai][bj][m][n], 0, 0, 0); } __builtin_amdgcn_s_setprio(0); } while (0)
#define PG8_WAIT_V(n) asm volatile("s_waitcnt vmcnt(" #n ")" ::: "memory")
#define PG8_WAIT_L(n) asm volatile("s_waitcnt lgkmcnt(" #n ")" ::: "memory")
#define PG8_BAR __builtin_amdgcn_s_barrier()
#define PG8_SCHED __builtin_amdgcn_sched_barrier(0)
#define PG8_ETAB_DMA(U, BUF) do { if (wid < 4) { int e_ = wid * 64 + lane; e_ = e_ < (U).nvalid ? e_ : (U).nvalid - 1; \
        glds16((const char*)(U).rows, (unsigned)e_ * 16u, ldsb + (unsigned)(ETAB_OFF + (BUF) * ETAB_BYTES) + ldsw); } } while (0)
#define PG8_GATHER_HALF(H, BUF, U) do { const int t2_ = wid * 64 + opaque(lane); _Pragma("unroll") for (int i = 0; i < 2; ++i) { int R_, C_; stage_rc(t2_ * 16 + i * 8192, R_, C_); \
        const unsigned tok_ = GATHER == 2 ? (unsigned)((U).tile * BM + R_ + (H) * HALF) : *(const LAS unsigned*)(lds + ETAB_OFF + (BUF) * ETAB_BYTES + (R_ + (H) * HALF) * 16); cvA[H][i] = (tok_ * (unsigned)g.lda + (unsigned)C_) * 2u; } } while (0)
    Unit cur, nxt; int ui = 0;
    if (!S.next(0, cur)) return;
    f32x4 acc[2][2][4][2];
#pragma unroll
    for (int a = 0; a < 2; ++a)
#pragma unroll
        for (int b = 0; b < 2; ++b)
#pragma unroll
            for (int m = 0; m < 4; ++m)
#pragma unroll
                for (int n = 0; n < 2; ++n) acc[a][b][m][n] = (f32x4){0.f, 0.f, 0.f, 0.f};
    bf16x8 At[FP8 != 0 ? 1 : 4][2], B0[FP8 != 0 ? 1 : 2][2], B1[FP8 != 0 ? 1 : 2][2];
    i32x8 At8[FP8 != 0 ? 4 : 1], B08[FP8 != 0 ? 2 : 1], B18[FP8 != 0 ? 2 : 1];
    (void)At; (void)B0; (void)B1; (void)At8; (void)B08; (void)B18;
    if constexpr (ETAB) { PG8_ETAB_DMA(cur, 0); PG8_WAIT_V(0); PG8_BAR; }
    if constexpr (GATHER != 0) { PG8_GATHER_HALF(0, 0, cur); PG8_GATHER_HALF(1, 0, cur); }
    const char* cA = cur.A; const char* cB = cur.B; const char* cB2 = cur.B2;
    PG8_STAGE(PG8_SB(0, 0), cB, voffB[0], voffB[1]); PG8_STAGE(PG8_SB(0, 1), cB + hstepB, voffB[0], voffB[1]); PG8_STAGE(PG8_SA(0, 0), cA, cvA[0][0], cvA[0][1]); PG8_STAGE(PG8_SA(0, 1), cA, cvA[1][0], cvA[1][1]);
    if (wr == 1) PG8_BAR;
    PG8_WAIT_V(2); PG8_BAR;
    PG8_STAGE(PG8_SB(1, 0), cB + kstep, voffB[0], voffB[1]); PG8_STAGE(PG8_SA(1, 0), cA + kstep, cvA[0][0], cvA[0][1]); PG8_STAGE(PG8_SB(1, 1), cB + hstepB + kstep, voffB[0], voffB[1]);
    PG8_WAIT_V(6); PG8_BAR;
    for (;;) {
        const bool has_next = S.next(ui + 1, nxt);
        const int ebn = (ui + 1) % 3;
        if constexpr (ETAB) { if (has_next) { PG8_ETAB_DMA(nxt, ebn); } }
        const char* nA = has_next ? nxt.A : cA; const char* nB = has_next ? nxt.B : cB;
#define PG8_KTRIP(F8T) { \
            const bool last = (t == nt - 2); \
            const char* a1 = cA + (size_t)(t + 1) * kstep; \
            const char* a2 = last ? nA : cA + (size_t)(t + 2) * kstep; \
            const char* bcur = (SPLITK && (t + 2) >= g.ksplit) ? cB2 : cB; \
            const char* b2 = last ? nB : bcur + (size_t)(t + 2) * kstep; \
            const char* a3 = a2 + kstep; const char* b3 = b2 + kstep; \
            if constexpr (GATHER != 0) { if (last && has_next) { PG8_GATHER_HALF(0, ebn, nxt); } } \
            if constexpr (SSQP) { if (t == 2) { const char* sp_ = g.aux + (size_t)cur.pm * 16384; glds16(sp_, (unsigned)(wid * 2048 + lane * 16), ldsb + (unsigned)ETAB_OFF + (unsigned)wid * 2048u); glds16(sp_, (unsigned)(wid * 2048 + 1024 + lane * 16), ldsb + (unsigned)ETAB_OFF + (unsigned)wid * 2048u + 1024u); } } \
            PG8_LDB(B0, 0, 0); PG8_LDB(B1, 0, 1); PG8_SCHED; PG8_LDA(At, 0, 0); PG8_STAGE(PG8_SA(1, 1), a1, cvA[1][0], cvA[1][1]); \
            if constexpr (GATHER != 0) { if (last && has_next) { PG8_GATHER_HALF(1, ebn, nxt); } } \
            PG8_WAIT_V(8); PG8_WAIT_L(0); PG8_BAR; PG8_MMA(0, 0, At, B0, F8T); PG8_MMA(0, 1, At, B1, F8T); PG8_BAR; PG8_SCHED; \
            PG8_LDA(At, 0, 1); PG8_STAGE(PG8_SB(0, 0), b2, voffB[0], voffB[1]); PG8_STAGE(PG8_SB(0, 1), b2 + hstepB, voffB[0], voffB[1]); PG8_STAGE(PG8_SA(0, 0), a2, cvA[0][0], cvA[0][1]); \
            PG8_WAIT_V(8); PG8_WAIT_L(0); PG8_BAR; PG8_MMA(1, 0, At, B0, F8T); PG8_MMA(1, 1, At, B1, F8T); PG8_BAR; PG8_SCHED; \
            PG8_LDB(B0, 1, 0); PG8_LDB(B1, 1, 1); PG8_SCHED; PG8_LDA(At, 1, 0); PG8_STAGE(PG8_SA(0, 1), a2, cvA[1][0], cvA[1][1]); \
            PG8_WAIT_V(8); PG8_WAIT_L(0); PG8_BAR; PG8_MMA(0, 0, At, B0, F8T); PG8_MMA(0, 1, At, B1, F8T); PG8_BAR; PG8_SCHED; \
            PG8_LDA(At, 1, 1); PG8_STAGE(PG8_SB(1, 0), b3, voffB[0], voffB[1]); PG8_STAGE(PG8_SB(1, 1), b3 + hstepB, voffB[0], voffB[1]); PG8_STAGE(PG8_SA(1, 0), a3, cvA[0][0], cvA[0][1]); \
            PG8_WAIT_V(8); PG8_WAIT_L(0); PG8_BAR; PG8_MMA(1, 0, At, B0, F8T); PG8_MMA(1, 1, At, B1, F8T); PG8_BAR; PG8_SCHED; }
        int t = 0;
        if constexpr (FP8 == 2) {
#pragma nounroll
            for (; t < g.mixk; t += 2) PG8_KTRIP(1)
#pragma nounroll
            for (; t < nt; t += 2) PG8_KTRIP(0)
        } else {
#pragma nounroll
            for (; t < nt; t += 2) PG8_KTRIP(FP8)
        }
#undef PG8_KTRIP
        if (wr == 0) PG8_BAR;
        { const int eoff = opaque_s(SSQP ? ETAB_OFF : ETAB_OFF + (ui % 3) * ETAB_BYTES);
          E(acc, cur, wr, wc, fr, fq, (const LAS u32x4*)(lds + eoff)); }
        if (!has_next) break;
#pragma unroll
        for (int a = 0; a < 2; ++a)
#pragma unroll
            for (int b = 0; b < 2; ++b)
#pragma unroll
                for (int m = 0; m < 4; ++m)
#pragma unroll
                    for (int n = 0; n < 2; ++n) acc[a][b][m][n] = (f32x4){0.f, 0.f, 0.f, 0.f};
        cur = nxt; cA = nA; cB = nB; cB2 = nxt.B2; ++ui;
        if (wr == 1) PG8_BAR;
    }
    PG8_WAIT_V(0);
    PG8_BAR;
#undef PG8_SA
#undef PG8_SB
#undef PG8_STAGE
#undef PG8_LDA
#undef PG8_LDB
#undef PG8_MMA
#undef PG8_LD16
#undef PG8_H0
#undef PG8_H1
#undef PG8_WAIT_V
#undef PG8_WAIT_L
#undef PG8_BAR
#undef PG8_SCHED
#undef PG8_ETAB_DMA
#undef PG8_GATHER_HALF
}

__device__ __forceinline__ u32x4 merge16(u32x2 P, u32x2 Q) {
    const auto r0 = __builtin_amdgcn_permlane16_swap(P.x, Q.x, false, false); const auto r1 = __builtin_amdgcn_permlane16_swap(P.y, Q.y, false, false);
    return (u32x4){r0[0], r1[0], r0[1], r1[1]}; }

struct EpiProj {
    static constexpr bool PERM = true;
    bf16* O; const float* ssq; int coff; float sc_q, sc_o; unsigned char* O8;
    __device__ __forceinline__ void operator()(const f32x4 (&acc)[2][2][4][2], const Unit& u, int wr, int wc, int fr_, int fq_, const LAS u32x4* et) const {
        const int fr = opaque(fr_), fq = opaque(fq_);
        const int row0 = u.pm * BM + wr * 64 + fr, col0 = coff + u.pn * BM + wc * 32 + 8 * fq; const float scx = u.pn < 2 ? sc_q : sc_o;
#pragma unroll
        for (int ai = 0; ai < 2; ++ai)
#pragma unroll
            for (int m = 0; m < 4; ++m) { const int row = row0 + ai * HALF + m * 16;
                const LAS f32x4* sp = (const LAS f32x4*)et + (ai * HALF + wr * 64 + m * 16 + fr) * 4; const f32x4 s0 = sp[0], s1 = sp[1], s2 = sp[2], s3 = sp[3];
                const f32x4 st = (s0 + s1) + (s2 + s3); const float rs = __builtin_amdgcn_rsqf(((st[0] + st[1]) + (st[2] + st[3])) * (1.0f / D) + EPS) * scx;
                bf16* rowp = O + (size_t)row * DIN + col0; unsigned char* rowp8 = O8 + (size_t)row * 1536 + col0 + ((fq & 1) ? HALF - 8 : 0);
                if (O8) { u32x2 w8[2];
#pragma unroll
                    for (int bj = 0; bj < 2; ++bj) { const f32x4 v0 = acc[ai][bj][m][0] * rs, v1 = acc[ai][bj][m][1] * rs; w8[bj].x = pk4_fp8(v0[0], v0[1], v0[2], v0[3]); w8[bj].y = pk4_fp8(v1[0], v1[1], v1[2], v1[3]); }
                    *(u32x4*)rowp8 = merge16(w8[0], w8[1]); }
                else {
#pragma unroll
                    for (int bj = 0; bj < 2; ++bj) { const f32x4 v0 = acc[ai][bj][m][0] * rs, v1 = acc[ai][bj][m][1] * rs;
                        u32x4 w; w.x = cvt_pk_bf16(v0[0], v0[1]); w.y = cvt_pk_bf16(v0[2], v0[3]); w.z = cvt_pk_bf16(v1[0], v1[1]); w.w = cvt_pk_bf16(v1[2], v1[3]);
                        *(u32x4*)(rowp + bj * HALF) = w; } } }
    }
};
struct EpiRes {
    static constexpr bool PERM = true;
    bf16* xb; unsigned char* x8;
    __device__ __forceinline__ void operator()(const f32x4 (&acc)[2][2][4][2], const Unit& u, int wr, int wc, int fr_, int fq_, const LAS u32x4* et) const {
        const int fr = opaque(fr_), fq = opaque(fq_);
        const int row0 = u.pm * BM + wr * 64 + fr, col0 = u.pn * BM + wc * 32 + 8 * fq;
        float DS = 1.0f / (SC_A8 * SC_WGU); asm volatile("" : "+v"(DS));
#pragma unroll
        for (int ai = 0; ai < 2; ++ai) {
            u32x4 xo[4][2];
#pragma unroll
            for (int m = 0; m < 4; ++m)
#pragma unroll
                for (int bj = 0; bj < 2; ++bj) xo[m][bj] = *(const u32x4*)(xb + (size_t)(row0 + ai * HALF + m * 16) * D + col0 + bj * HALF);
            asm volatile("" ::: "memory");
#pragma unroll
            for (int m = 0; m < 4; ++m) { const size_t ro = (size_t)(row0 + ai * HALF + m * 16) * D + col0; u32x2 q8[2];
#pragma unroll
                for (int bj = 0; bj < 2; ++bj) { const u32x4 w0 = xo[m][bj]; const f32x4 a0 = acc[ai][bj][m][0], a1 = acc[ai][bj][m][1]; u32x4 w;
                    const float v0 = __builtin_fmaf(a0[0], DS, bf_lo(w0.x)), v1 = __builtin_fmaf(a0[1], DS, bf_hi(w0.x)), v2 = __builtin_fmaf(a0[2], DS, bf_lo(w0.y)), v3 = __builtin_fmaf(a0[3], DS, bf_hi(w0.y)), v4 = __builtin_fmaf(a1[0], DS, bf_lo(w0.z)), v5 = __builtin_fmaf(a1[1], DS, bf_hi(w0.z)), v6 = __builtin_fmaf(a1[2], DS, bf_lo(w0.w)), v7 = __builtin_fmaf(a1[3], DS, bf_hi(w0.w));
                    w.x = cvt_pk_bf16(v0, v1); w.y = cvt_pk_bf16(v2, v3); w.z = cvt_pk_bf16(v4, v5); w.w = cvt_pk_bf16(v6, v7);
                    *(u32x4*)(xb + ro + bj * HALF) = w;
                    q8[bj].x = pk4_fp8(v0 * SC_X8, v1 * SC_X8, v2 * SC_X8, v3 * SC_X8); q8[bj].y = pk4_fp8(v4 * SC_X8, v5 * SC_X8, v6 * SC_X8, v7 * SC_X8); }
                *(u32x4*)(x8 + ro + ((fq & 1) ? HALF - 8 : 0)) = merge16(q8[0], q8[1]); }
            asm volatile("" ::: "memory"); }
    }
};
struct EpiSwiglu {
    static constexpr bool PERM = true;
    unsigned char* H;
    __device__ __forceinline__ void operator()(const f32x4 (&acc)[2][2][4][2], const Unit& u, int wr, int wc, int fr_, int fq_, const LAS u32x4* et) const {
        const int fr = opaque(fr_), fq = opaque(fq_);
        const int ehalf = u.sub >> 2, jblk = u.sub & 3;
        const int col0 = ehalf * DE + jblk * HALF + wc * 32 + 8 * fq;
#pragma unroll
        for (int ai = 0; ai < 2; ++ai)
#pragma unroll
            for (int mp = 0; mp < 2; ++mp) { u32x2 o[2];
#pragma unroll
                for (int mm = 0; mm < 2; ++mm) { const int m = 2 * mp + mm; const int lr = ai * HALF + wr * 64 + m * 16 + fr;
                    const u32x4 e = et[lr]; const unsigned ey = e.y, ew = ehalf ? e.w : e.z;
                    const float rs = __uint_as_float(ey), w = __uint_as_float(ew);
                    float hv[8];
#pragma unroll
                    for (int n = 0; n < 2; ++n)
#pragma unroll
                        for (int k = 0; k < 4; ++k) { const float gt = acc[ai][0][m][n][k] * rs, up = acc[ai][1][m][n][k] * rs;
                            const float sg = gt * fast_rcp(1.0f + fast_exp2(-LOG2E * gt)); hv[n * 4 + k] = sg * up * w; }
                    o[mm].x = pk4_fp8(hv[0], hv[1], hv[2], hv[3]); o[mm].y = pk4_fp8(hv[4], hv[5], hv[6], hv[7]); }
                const int lrs = ai * HALF + wr * 64 + (2 * mp + (fq & 1)) * 16 + fr;
                *(u32x4*)(H + (size_t)(u.tile * BM + lrs) * D + col0 - ((fq & 1) ? 8 : 0)) = merge16(o[0], o[1]); }
    }
};
struct EpiScatter {
    static constexpr bool PERM = true;
    bf16* xb; float* ssq; unsigned char* x8;
    __device__ __forceinline__ void operator()(const f32x4 (&acc)[2][2][4][2], const Unit& u, int wr, int wc, int fr_, int fq_, const LAS u32x4* et) const {
        const int fr = opaque(fr_), fq = opaque(fq_);
        const int col0 = u.pn * BM + wc * 32 + 8 * fq;
        float DS = 1.0f / (SC_H8 * SC_WD); asm volatile("" : "+v"(DS));
#pragma unroll
        for (int ai = 0; ai < 2; ++ai) {
            unsigned tok[4]; u32x4 xo[4][2];
#pragma unroll
            for (int m = 0; m < 4; ++m) tok[m] = et[ai * HALF + wr * 64 + m * 16 + fr].x;
#pragma unroll
            for (int m = 0; m < 4; ++m)
#pragma unroll
                for (int bj = 0; bj < 2; ++bj) xo[m][bj] = *(const u32x4*)(xb + (size_t)tok[m] * D + col0 + bj * HALF);
            asm volatile("" ::: "memory");
#pragma unroll
            for (int m = 0; m < 4; ++m) { const int lr = ai * HALF + wr * 64 + m * 16 + fr; const bool valid = lr < u.nvalid; const size_t ro = (size_t)tok[m] * D + col0; float ss = 0.f; u32x2 q8[2];
#pragma unroll
                for (int bj = 0; bj < 2; ++bj) { const u32x4 w0 = xo[m][bj]; const f32x4 a0 = acc[ai][bj][m][0], a1 = acc[ai][bj][m][1]; u32x4 w;
                    w.x = cvt_pk_bf16(__builtin_fmaf(a0[0], DS, bf_lo(w0.x)), __builtin_fmaf(a0[1], DS, bf_hi(w0.x))); w.y = cvt_pk_bf16(__builtin_fmaf(a0[2], DS, bf_lo(w0.y)), __builtin_fmaf(a0[3], DS, bf_hi(w0.y)));
                    w.z = cvt_pk_bf16(__builtin_fmaf(a1[0], DS, bf_lo(w0.z)), __builtin_fmaf(a1[1], DS, bf_hi(w0.z))); w.w = cvt_pk_bf16(__builtin_fmaf(a1[2], DS, bf_lo(w0.w)), __builtin_fmaf(a1[3], DS, bf_hi(w0.w)));
                    const float r0 = bf_lo(w.x), r1 = bf_hi(w.x), r2 = bf_lo(w.y), r3 = bf_hi(w.y), r4 = bf_lo(w.z), r5 = bf_hi(w.z), r6 = bf_lo(w.w), r7 = bf_hi(w.w);
                    ss += ((r0 * r0 + r1 * r1) + (r2 * r2 + r3 * r3)) + ((r4 * r4 + r5 * r5) + (r6 * r6 + r7 * r7));
                    q8[bj].x = pk4_fp8(r0 * SC_X8, r1 * SC_X8, r2 * SC_X8, r3 * SC_X8); q8[bj].y = pk4_fp8(r4 * SC_X8, r5 * SC_X8, r6 * SC_X8, r7 * SC_X8);
                    if (valid) *(u32x4*)(xb + ro + bj * HALF) = w; }
                { const u32x4 q16 = merge16(q8[0], q8[1]);
                  if (valid) *(u32x4*)(x8 + ro + ((fq & 1) ? HALF - 8 : 0)) = q16; }
                ss += __shfl_xor(ss, 16); ss += __shfl_xor(ss, 32);
                if (valid && fq == 0) ssq[(size_t)tok[m] * 16 + u.pn * 4 + wc] = ss; }
            asm volatile("" ::: "memory"); }
    }
};
}

template <int SUB> struct MoeOrder {
    const volatile LAS int* tb;
    const volatile LAS int* cnt;
    int nunits, G, c;
    const char* A; const char* W; const u32x4* list;
    __device__ __forceinline__ bool next(int i, pg8::Unit& u) const {
        const int L = i * G + c; if (L >= nunits) return false;
        const int tile = L / SUB, sub = L % SUB;
        int k = 0; while (tb[k + 1] <= tile) ++k;
        const int tin = tile - tb[k]; const int rem = cnt[k] - tin * 256;
        u.nvalid = rem < 256 ? rem : 256; u.rows = list + (size_t)k * T + (size_t)tin * 256; u.tile = tile; u.sub = sub; u.pm = tile;
        const int gi = k / 6, p = k % 6; const int a = p < 3 ? 0 : (p < 5 ? 1 : 2); const int b = p < 3 ? p + 1 : (p < 5 ? p - 1 : 3);
        const int ea = gi * 4 + a, eb = gi * 4 + b;
        if (SUB == 8) {
            const int ehalf = sub >> 2, jblk = sub & 3; u.pn = sub; u.A = A;
            u.B = W + ((size_t)(ehalf ? eb : ea) * 1024 + (size_t)jblk * 128) * (size_t)D; u.B2 = u.B;
        } else {
            u.pn = sub; u.A = A;
            u.B = W + ((size_t)ea * 1024 + (size_t)sub * 256) * (size_t)DE;
            u.B2 = W + ((size_t)eb * 1024 + (size_t)sub * 256) * (size_t)DE - (size_t)4 * 128;
        }
        return true;
    }
};

__device__ __forceinline__ float wave_sum(float v) {
#pragma unroll
    for (int o = 1; o < 64; o <<= 1) v += __shfl_xor(v, o);
    return v;
}
__device__ __forceinline__ void weff_task(const float* pw, const float* ps, const float* wo, unsigned char* WT, int g, int kb8, int n0, int lane) {
    const float* wog = wo + (size_t)(512 + g * 128) * D + n0 + lane; const float* psg = ps + g * 128; const float* pr = pw + ((size_t)g * 128 + kb8 * 8) * 128;
    float a[8];
#pragma unroll
    for (int q = 0; q < 8; ++q) a[q] = 0.f;
    for (int j0 = 0; j0 < 128; j0 += 32) { float wv[32];
#pragma unroll
        for (int jj = 0; jj < 32; ++jj) wv[jj] = wog[(size_t)(j0 + jj) * D];
#pragma unroll
        for (int jj = 0; jj < 32; ++jj) { const float sw = wv[jj] * psg[j0 + jj];
#pragma unroll
            for (int q = 0; q < 8; ++q) a[q] += pr[q * 128 + j0 + jj] * sw; } }
    constexpr float WS_ = SC_A8 * SC_WGU;
    u32x4 o; o.x = pk2(a[0] * WS_, a[1] * WS_); o.y = pk2(a[2] * WS_, a[3] * WS_); o.z = pk2(a[4] * WS_, a[5] * WS_); o.w = pk2(a[6] * WS_, a[7] * WS_);
    *(u32x4*)(WT + (size_t)(n0 + lane) * MIXP + 512 + (size_t)(g * 128 + kb8 * 8) * 2) = o;
}

#define CONVERT_WEIGHTS(L0_, L1_, GW_, NGW_) { \
        constexpr int I_IN = 16 * 64, I_OT = 8 * 32, I_G = 16 * 16, I_D = 8 * 32; \
        constexpr int PER_LAYER = I_IN + I_OT + NE * (2 * I_G + I_D); const int cfirst_ = (L0_) * PER_LAYER + (GW_), NCONV = (L1_) * PER_LAYER; \
        struct Item { const float* W; const float* ks; unsigned char* dst; int ldw, k0, n0, pitch, f8; float ns; }; \
        auto decode = [&](int it) -> Item { Item I; const int l = it / PER_LAYER; int r = it % PER_LAYER; \
            if (r < I_IN) { const int kb = r / 64, nb = r % 64; I.W = w_in + (size_t)l * D * DIN; I.ldw = DIN; I.ks = norm_mix_g + l * D; I.k0 = 64 * kb; I.n0 = 32 * nb; \
                if (nb < 48) { I.dst = Win8 + (size_t)l * 1536 * D; I.pitch = D; I.f8 = 1; I.ns = SC_WGU; } \
                else { I.dst = (unsigned char*)(Win_t + (size_t)l * DIN * D); I.pitch = D * 2; I.f8 = 0; I.ns = 1.0f; } \
                return I; } r -= I_IN; \
            if (r < I_OT) { const int kb = r / 32, nb = r % 32; I.W = w_out + (size_t)l * D * D; I.ldw = D; I.ks = nullptr; I.k0 = 64 * kb; I.n0 = 32 * nb; I.dst = Wout8 + (size_t)l * D * MIXP; I.pitch = MIXP; I.f8 = 1; I.ns = SC_WGU; return I; } r -= I_OT; \
            const int e = r / (2 * I_G + I_D); r %= (2 * I_G + I_D); const size_t le = (size_t)l * NE + e; \
            if (r < 2 * I_G) { const int up = r >= I_G; r -= up * I_G; const int kb = r / 16, nb = r % 16; I.W = (up ? w_up : w_gate) + le * D * DE; I.ldw = DE; I.ks = norm_ffn_g + l * D; I.k0 = 64 * kb; I.n0 = 32 * nb; \
                I.dst = Wgu8 + le * 1024 * D + (size_t)(up ? 512 : 0) * D; I.pitch = D; I.f8 = 1; I.ns = SC_WGU; return I; } r -= 2 * I_G; \
            { const int kb = r / 32, nb = r % 32; I.W = w_down + le * DE * D; I.ldw = D; I.ks = nullptr; I.k0 = 64 * kb; I.n0 = 32 * nb; I.dst = Wd8 + le * 1024 * DE; I.pitch = DE; I.f8 = 1; I.ns = SC_WD; return I; } }; \
        float cur[32], nxt[32], nx2[32]; \
_Pragma("unroll") \
        for (int i = 0; i < 32; ++i) { cur[i] = 0.f; nxt[i] = 0.f; nx2[i] = 0.f; } \
        if (cfirst_ < NCONV) { const Item I = decode(cfirst_); \
_Pragma("unroll") \
            for (int i = 0; i < 32; ++i) cur[i] = I.W[(size_t)(I.k0 + 2 * i + (lane >> 5)) * I.ldw + I.n0 + (lane & 31)]; } \
        if (cfirst_ + (NGW_) < NCONV) { const Item I = decode(cfirst_ + (NGW_)); \
_Pragma("unroll") \
            for (int i = 0; i < 32; ++i) nxt[i] = I.W[(size_t)(I.k0 + 2 * i + (lane >> 5)) * I.ldw + I.n0 + (lane & 31)]; } \
        for (int it = cfirst_; it < NCONV; it += (NGW_)) { \
            const Item I = decode(it); \
            if (it + 2 * (NGW_) < NCONV) { const Item J = decode(it + 2 * (NGW_)); \
_Pragma("unroll") \
                for (int i = 0; i < 32; ++i) nx2[i] = J.W[(size_t)(J.k0 + 2 * i + (lane >> 5)) * J.ldw + J.n0 + (lane & 31)]; } \
_Pragma("unroll") \
            for (int i = 0; i < 32; ++i) { const int kk = 2 * i + (lane >> 5); float v = cur[i]; if (I.ks) v *= I.ks[I.k0 + kk]; scr[kk * 33 + (lane & 31)] = v * I.ns; } \
            LDS_WAIT(); asm volatile("" ::: "memory"); \
            const int c = lane & 7; \
_Pragma("unroll") \
            for (int j = 0; j < 4; ++j) { const int n = (lane >> 3) + 8 * j; const LAS float* s = scr + (8 * c) * 33 + n; \
                if (I.f8) { u32x2 o; o.x = pk4_fp8(s[0 * 33], s[1 * 33], s[2 * 33], s[3 * 33]); o.y = pk4_fp8(s[4 * 33], s[5 * 33], s[6 * 33], s[7 * 33]); \
                    *(u32x2*)(I.dst + (size_t)(I.n0 + n) * I.pitch + I.k0 + 8 * c) = o; } \
                else { u32x4 o; o.x = pk2(s[0 * 33], s[1 * 33]); o.y = pk2(s[2 * 33], s[3 * 33]); o.z = pk2(s[4 * 33], s[5 * 33]); o.w = pk2(s[6 * 33], s[7 * 33]); \
                    *(u32x4*)(I.dst + (size_t)(I.n0 + n) * I.pitch + (size_t)(I.k0 + 8 * c) * 2) = o; } } \
            LDS_WAIT(); asm volatile("" ::: "memory"); \
_Pragma("unroll") \
            for (int i = 0; i < 32; ++i) { cur[i] = nxt[i]; nxt[i] = nx2[i]; } \
        } \
        for (int it = (L0_) * 1024 + (GW_); it < (L1_) * 1024; it += (NGW_)) { const int l = it >> 10, r = it & 1023, g = r >> 8, kb8 = (r >> 4) & 15, nc = r & 15; \
            weff_task(pool_w + (size_t)l * 4 * 128 * 128, pool_scale + l * 512, w_out + (size_t)l * D * D, Wout8 + (size_t)l * D * MIXP, g, kb8, 64 * nc, lane); } \
        for (int it = (L0_) * 4096 + (GW_) * 64 + lane; it < (L1_) * 4096; it += (NGW_) * 64) { \
            const int l = it >> 12, step = (it >> 6) & 63, ln = it & 63, m = ln & 31, kg = ln >> 5, kb = (step >> 2) * 64 + kg * 32 + (step & 3) * 8; \
            unsigned hw[4], lw[4]; \
_Pragma("unroll") \
            for (int jj = 0; jj < 4; ++jj) { float v[2]; \
_Pragma("unroll") \
                for (int q = 0; q < 2; ++q) { const int k = kb + 2 * jj + q; float w = 0.f; \
                    if (m < 8) w = w_rg[((size_t)l * D + k) * 4 + (m & 3)]; else if (m < 24) w = w_re[((size_t)l * D + k) * 16 + (m - 8)]; \
                    v[q] = w * norm_ffn_g[l * D + k]; } \
                const unsigned h = pk2(v[0], v[1]); hw[jj] = h; lw[jj] = pk2(v[0] - bf_lo(h), v[1] - bf_hi(h)); } \
            rfrag[(size_t)l * 8192 + (size_t)(0 * 64 + step) * 64 + ln] = (u32x4){hw[0], hw[1], hw[2], hw[3]}; \
            rfrag[(size_t)l * 8192 + (size_t)(1 * 64 + step) * 64 + ln] = (u32x4){lw[0], lw[1], lw[2], lw[3]}; \
        } }

struct Args { const float* in[14]; float* out; unsigned char* ws; int ph_lo, ph_hi, li, pad; };
constexpr int N_PHASES = 2 + 6 * DEPTH;

__global__ void __launch_bounds__(NTHREADS, 2) enc_fwd(Args args) {
    extern __shared__ __attribute__((aligned(16))) unsigned char lds_raw[];
    LAS unsigned char* lds = (LAS unsigned char*)lds_raw;
    volatile LAS unsigned* MISC = (volatile LAS unsigned*)(lds + MISC_OFF);
    const int wave_s = __builtin_amdgcn_readfirstlane((int)threadIdx.x >> 6);
    const int G = gridDim.x; const int bx = blockIdx.x; const int vcu = (G % 8 == 0) ? (bx % 8) * (G / 8) + bx / 8 : bx;
    unsigned char* ws = args.ws;
    gu32* ctl = (gu32*)(ws + WS_CTL);
    const float* x_in = args.in[0]; const float* norm_mix_g = args.in[1]; const float* w_in = args.in[2]; const float* rpb = args.in[3];
    const float* pool_w = args.in[4]; const float* pool_scale = args.in[5]; const float* w_out = args.in[6]; const float* norm_ffn_g = args.in[7];
    const float* w_rg = args.in[8]; const float* w_re = args.in[9]; const float* w_gate = args.in[10]; const float* w_up = args.in[11]; const float* w_down = args.in[12];
    const float* final_g = args.in[13];
#define WS_PTRS() GAS unsigned char* wsg_ = (GAS unsigned char*)ws; asm volatile("" : "+s"(wsg_)); unsigned char* wsp = (unsigned char*)wsg_;     \
    bf16* Win_t = (bf16*)(wsp + WS_WIN); bf16* Wout_t = (bf16*)(wsp + WS_WOUT); unsigned char* Wgu8 = wsp + WS_WGU; unsigned char* Wd8 = wsp + WS_WD; unsigned char* x8 = wsp + WS_X8; unsigned char* H8 = wsp + WS_H; unsigned char* Win8 = wsp + WS_WIN8; unsigned char* qkv8 = wsp + WS_QKV8; \
    u32x4* rfrag = (u32x4*)(wsp + WS_RFRAG); float* ssq = (float*)(wsp + WS_SSQ); u32x4* list = (u32x4*)(wsp + WS_LIST); \
    bf16* xb = (bf16*)(wsp + WS_XB); bf16* proj = (bf16*)(wsp + WS_PROJ); unsigned char* mix8 = wsp + WS_MIX; unsigned char* Wout8 = wsp + WS_WOUT; \
    (void)Win_t; (void)Win8; (void)qkv8; (void)Wout_t; (void)Wgu8; (void)Wd8; (void)x8; (void)H8; (void)rfrag; (void)ssq; (void)list; (void)xb; (void)proj; (void)mix8; (void)Wout8

    for (int u = threadIdx.x; u < 128; u += NTHREADS) MISC[u] = 0u;
    __syncthreads();
    XcdBarrier bar; bar.bar = (unsigned*)(ctl + CW_BAR); bar.x = 0; bar.st = nullptr;
    if (MK_N_LAUNCHES == 1) bar = xcd_barrier_post((unsigned*)(ctl + CW_BAR), MISC + MW_BAR);
    const int lo = args.ph_lo, hi = args.ph_hi;
#define IN(k) (lo <= (k) && (k) < hi)
#define SEAM(k) do { if (IN(k) && IN((k) + 1)) xcd_barrier(bar, wave_s == 0 && lane_id() == 0); } while (0)
    const int NGW = G * NWAVES;
#define PHASE_IDS() const int wave = opaque_s(wave_s), lane = lane_id(), tid = wave * 64 + lane, gw = opaque_s(vcu) * NWAVES + wave; (void)gw; (void)tid

    if (IN(0)) for (int rep_ = 0; rep_ < REP_P0; ++rep_) {
        WS_PTRS();
        PHASE_IDS();
        __syncthreads();
        LAS float* scr = (LAS float*)(lds + wave * 16384);
        CONVERT_WEIGHTS(0, 1, gw, NGW)
        for (int m0 = gw * 4; m0 < T; m0 += NGW * 4) {
            f32x4 v[4][4];
#pragma unroll
            for (int rr = 0; rr < 4; ++rr) { const f32x4* xr = (const f32x4*)(x_in + (size_t)(m0 + rr) * D) + lane;
#pragma unroll
                for (int j = 0; j < 4; ++j) v[rr][j] = xr[64 * j]; }
#pragma unroll
            for (int rr = 0; rr < 4; ++rr) { float s = 0.f;
#pragma unroll
                for (int j = 0; j < 4; ++j) s += (v[rr][j][0] * v[rr][j][0] + v[rr][j][1] * v[rr][j][1]) + (v[rr][j][2] * v[rr][j][2] + v[rr][j][3] * v[rr][j][3]);
                s = wave_sum(s);
                u32x2* o8 = (u32x2*)(xb + (size_t)(m0 + rr) * D) + lane;
#pragma unroll
                for (int j = 0; j < 4; ++j) { u32x2 w; w.x = cvt_pk_bf16(v[rr][j][0], v[rr][j][1]); w.y = cvt_pk_bf16(v[rr][j][2], v[rr][j][3]); o8[64 * j] = w;
                    ((unsigned*)(x8 + (size_t)(m0 + rr) * D))[lane + 64 * j] = pk4_fp8(v[rr][j][0] * SC_X8, v[rr][j][1] * SC_X8, v[rr][j][2] * SC_X8, v[rr][j][3] * SC_X8); }
                if (lane < 16) ssq[(size_t)(m0 + rr) * 16 + lane] = lane == 0 ? s : 0.f; }
        }
        LDS_WAIT();
    }
    SEAM(0);

    for (int l = 0; l < DEPTH; ++l) {
        const int pb = 1 + 6 * l;
        if (IN(pb)) for (int rep_ = 0; rep_ < REP_P1; ++rep_) {
        WS_PTRS();
            {
                pg8::Gemm g{D / 2, D / 2, D / 2, 1 << 20, (unsigned)(128 * D), (const char*)ssq};
                pg8::StaticOrder S; S.init(x8, Win8 + (size_t)l * 1536 * D, D / 2, D / 2, T, 1536, G, opaque_s(bx), 1);
                pg8::EpiProj E{proj, ssq, 0, SC_Q8 * 0.125f * LOG2E / (SC_X8 * SC_WGU), SC_KV8 / (SC_X8 * SC_WGU), qkv8};
                pg8::gemm_phase<pg8::EpiProj, pg8::StaticOrder, false, 2, false, true, true>(lds, wave_s, g, S, E); }
            {
                pg8::Gemm g{D, D, D, 1 << 20, (unsigned)(128 * D * 2), (const char*)ssq};
                pg8::StaticOrder S; S.init(xb, Win_t + ((size_t)l * DIN + 1536) * D, D, D, T, 512, G, opaque_s(bx), 0);
                pg8::EpiProj E{proj, ssq, 1536, 1.0f, 1.0f, nullptr};
                pg8::gemm_phase<pg8::EpiProj, pg8::StaticOrder, false, 0, false, false, true>(lds, wave_s, g, S, E); }
        }
        SEAM(pb);
        if (IN(pb + 1)) for (int rep_ = 0; rep_ < REP_P2; ++rep_) {
        WS_PTRS();
        PHASE_IDS();
            LAS float* rpbs = (LAS float*)(lds + BIAS_OFF);
            const int g4 = lane >> 4, q = lane & 15, n = wave & 3, rpar = wave >> 2;
            const int kcs = (n == 0) ? 0 : (n == 1) ? 8 : (n == 2) ? 24 : 32;
            const int qc = 16 * n + q, qs = (qc - 8) < 0 ? 0 : ((qc - 8) > 48 ? 48 : (qc - 8));
            bool pooled_inline = false;
            for (int bh = bx; bh < BATCH * NH; bh += G) {
                const int b = bh >> 3, h = bh & 7;
                __syncthreads();
                for (int i = tid; i < 465; i += NTHREADS) rpbs[i] = rpb[((size_t)l * NH + h) * 465 + i] * LOG2E;
                const int kvh = tid >> 8, ctok = (tid & 255) >> 2, c4 = tid & 3, csw = kvh ? (((ctok >> 1) & 3) << 1) : ((ctok >> 1) & 7);
                const unsigned wofs0 = (unsigned)((kvh ? VRING_OFF : KRING_OFF) + ctok * 128 + (((2 * c4) ^ csw) * 16)), wofs1 = (unsigned)((kvh ? VRING_OFF : KRING_OFF) + ctok * 128 + (((2 * c4 + 1) ^ csw) * 16));
                const unsigned char* kvsrc = qkv8 + (size_t)(b * SEQ + ctok) * 1536 + 512 + kvh * 512 + h * 64 + c4 * 16;
#define RING_PUT(SLOT_, W_) do { const u32x4 w__ = (W_); const u32x2 a_ = fp8x4_to_bf16x4(w__[0], 1.0f), b_ = fp8x4_to_bf16x4(w__[1], 1.0f), c_ = fp8x4_to_bf16x4(w__[2], 1.0f), d_ = fp8x4_to_bf16x4(w__[3], 1.0f); \
                    *(LAS u32x4*)(lds + (SLOT_) * 8192 + wofs0) = (u32x4){a_[0], a_[1], b_[0], b_[1]}; *(LAS u32x4*)(lds + (SLOT_) * 8192 + wofs1) = (u32x4){c_[0], c_[1], d_[0], d_[1]}; } while (0)
#pragma unroll
                for (int half = 0; half < 2; ++half) { u32x4 kv[4];
#pragma unroll
                    for (int j = 0; j < 4; ++j) { const int kr = half * 4 + j; kv[j] = __builtin_nontemporal_load((const u32x4*)(kvsrc + (size_t)kr * 64 * 1536)); }
#pragma unroll
                    for (int j = 0; j < 4; ++j) { const int kr = half * 4 + j; RING_PUT(kr, kv[j]); } }
                int hi_loaded = 7, cur_shift = 1000;
                const unsigned char* qbase = qkv8 + (size_t)(b * SEQ + 16 * n + q) * 1536 + h * 64 + 8 * g4;
                u32x2 qn0 = *(const u32x2*)(qbase + (size_t)rpar * 64 * 1536), qn1 = *(const u32x2*)(qbase + (size_t)rpar * 64 * 1536 + 32);
                const int w0 = qs - kcs;
                const bool sel0_0 = (4 * g4 + 0) >= w0, sel0_1 = (4 * g4 + 1) >= w0, sel0_2 = (4 * g4 + 2) >= w0, sel0_3 = (4 * g4 + 3) >= w0;
                const unsigned m01 = (sel0_0 ? 0x0000ffffu : 0u) | (sel0_1 ? 0xffff0000u : 0u), m23 = (sel0_2 ? 0x0000ffffu : 0u) | (sel0_3 ? 0xffff0000u : 0u);
                unsigned bmp[8][2];
#pragma unroll
                for (int i = 0; i < 8; ++i) { bmp[i][0] = 0u; bmp[i][1] = 0u; }
                const int prg = bx * NWAVES + wave; const bool do_pool = (bh == bx) && (prg < T / 32);
                const int phalf = 1 << (lane >> 4), ptb0 = (prg * 32) % SEQ;
                const bf16* pub = proj + (size_t)((prg * 32) / SEQ) * SEQ * DIN + 1536 + lane * 8; unsigned char* pob = mix8 + (size_t)((prg * 32) / SEQ) * SEQ * MIXP + 512 + lane * 16;
                float psum[8];
#pragma unroll
                for (int c = 0; c < 8; ++c) psum[c] = 0.f;
                if (do_pool) { for (int d = -8; d < 8; ++d) { const int j = ptb0 + d; if (d >= -phalf && d < phalf && j >= 0 && j < SEQ) { const u32x4 w = *(const u32x4*)(pub + (size_t)j * DIN);
                        psum[0] += bf_lo(w.x); psum[1] += bf_hi(w.x); psum[2] += bf_lo(w.y); psum[3] += bf_hi(w.y); psum[4] += bf_lo(w.z); psum[5] += bf_hi(w.z); psum[6] += bf_lo(w.w); psum[7] += bf_hi(w.w); } } }
                pooled_inline = pooled_inline || do_pool;
                __syncthreads();
                for (int s = 0; s < 16; ++s) {
                    const int r = 2 * s + rpar;
                    u32x4 pl_[2][3];
#pragma unroll
                    for (int tt = 0; tt < 2; ++tt) { const int t = ptb0 + 2 * s + tt; const int ta = (t + phalf) > SEQ - 1 ? SEQ - 1 : (t + phalf), ts = (t - phalf) < 0 ? 0 : (t - phalf);
                        pl_[tt][0] = *(const u32x4*)(pub + (size_t)t * DIN); pl_[tt][1] = *(const u32x4*)(pub + (size_t)ta * DIN); pl_[tt][2] = *(const u32x4*)(pub + (size_t)ts * DIN); }
                    int next_hi = hi_loaded;
                    if (s < 15) { int rs1 = 2 * s + 3 - 4; rs1 = rs1 < 0 ? 0 : (rs1 > 24 ? 24 : rs1); next_hi = rs1 + 7; }
                    const int nnew = next_hi - hi_loaded;
                    u32x4 pk_[2];
#pragma unroll
                    for (int j = 0; j < 2; ++j) { int kr = hi_loaded + 1 + j; kr = kr > ROWS - 1 ? ROWS - 1 : kr;
                        pk_[j] = __builtin_nontemporal_load((const u32x4*)(kvsrc + (size_t)kr * 64 * 1536)); }
                    int rst = r - 4; rst = rst < 0 ? 0 : (rst > 24 ? 24 : rst);
                    const int shift = rst - r;
                    if (shift != cur_shift) { cur_shift = shift;
#pragma unroll
                        for (int i = 0; i < 8; ++i) { float bv[4];
#pragma unroll
                            for (int e = 0; e < 4; ++e) { const int c = 4 * g4 + e; const int kc = kcs + (c >= w0 ? c : 16 + c);
                                int dc = kc - qc + 15; dc = dc < 0 ? 0 : (dc > 30 ? 30 : dc); const int dr = shift + i + 7;
                                bv[e] = rpbs[dr * 31 + dc]; }
                            bmp[i][0] = cvt_pk_bf16(bv[0], bv[1]); bmp[i][1] = cvt_pk_bf16(bv[2], bv[3]); } }
                    const size_t tq = (size_t)(b * SEQ + r * 64 + 16 * n + q);
                    bf16x8 qf0, qf1;
                    { constexpr float QS = 1.0f / (SC_Q8 * SC_KV8); const u32x2 a0 = fp8x4_to_bf16x4(qn0.x, QS), a1 = fp8x4_to_bf16x4(qn0.y, QS), b0 = fp8x4_to_bf16x4(qn1.x, QS), b1 = fp8x4_to_bf16x4(qn1.y, QS);
                      qf0 = __builtin_bit_cast(bf16x8, (u32x4){a0.x, a0.y, a1.x, a1.y}); qf1 = __builtin_bit_cast(bf16x8, (u32x4){b0.x, b0.y, b1.x, b1.y}); }
                    { const int rn = (r + 2) > ROWS - 1 ? ROWS - 1 : (r + 2); qn0 = *(const u32x2*)(qbase + (size_t)rn * 64 * 1536); qn1 = *(const u32x2*)(qbase + (size_t)rn * 64 * 1536 + 32); }
                    f32x4 sc[8][2];
                    const int slot0 = rst % 9;
#pragma unroll
                    for (int i = 0; i < 8; ++i) { int slot = slot0 + i; slot = slot >= 9 ? slot - 9 : slot;
                        const f32x4 binit = (f32x4){bf_lo(bmp[i][0]), bf_hi(bmp[i][0]), bf_lo(bmp[i][1]), bf_hi(bmp[i][1])};
#pragma unroll
                        for (int jb = 0; jb < 2; ++jb) { const int tok = kcs + 16 * jb + q; const int sw = (tok >> 1) & 7;
                            const LAS unsigned char* kp = lds + KRING_OFF + slot * 8192 + tok * 128;
                            const bf16x8 k0 = *(const LAS bf16x8*)(kp + ((g4 ^ sw) * 16)), k1 = *(const LAS bf16x8*)(kp + (((4 + g4) ^ sw) * 16));
                            f32x4 a = __builtin_amdgcn_mfma_f32_16x16x32_bf16(k0, qf0, binit, 0, 0, 0);
                            sc[i][jb] = __builtin_amdgcn_mfma_f32_16x16x32_bf16(k1, qf1, a, 0, 0, 0); } }
                    float sv[8][4];
#pragma unroll
                    for (int i = 0; i < 8; ++i) { sv[i][0] = sel0_0 ? sc[i][0][0] : sc[i][1][0]; sv[i][1] = sel0_1 ? sc[i][0][1] : sc[i][1][1]; sv[i][2] = sel0_2 ? sc[i][0][2] : sc[i][1][2]; sv[i][3] = sel0_3 ? sc[i][0][3] : sc[i][1][3]; }
                    float mxa = max3f(sv[0][0], sv[0][1], sv[0][2]), mxb = max3f(sv[0][3], sv[1][0], sv[1][1]);
                    mxa = max3f(mxa, sv[1][2], sv[1][3]);
#pragma unroll
                    for (int i = 2; i < 8; ++i) { mxa = max3f(mxa, sv[i][0], sv[i][1]); mxb = max3f(mxb, sv[i][2], sv[i][3]); }
                    float mx = fmaxf(mxa, mxb);
                    mx = fmaxf(mx, __shfl_xor(mx, 16)); mx = fmaxf(mx, __shfl_xor(mx, 32));
                    f32x2 lsum2 = (f32x2){0.f, 0.f}; const f32x2 mx2 = (f32x2){mx, mx}; bf16x8 pf[8];
#pragma unroll
                    for (int i = 0; i < 8; ++i) { const f32x2 d01 = (f32x2){sv[i][0], sv[i][1]} - mx2, d23 = (f32x2){sv[i][2], sv[i][3]} - mx2;
                        f32x2 p01, p23; p01.x = fast_exp2(d01.x); p01.y = fast_exp2(d01.y); p23.x = fast_exp2(d23.x); p23.y = fast_exp2(d23.y);
                        lsum2 += p01 + p23;
                        const unsigned pk01 = cvt_pk_bf16(p01.x, p01.y), pk23 = cvt_pk_bf16(p23.x, p23.y);
                        u32x4 w; w.x = pk01 & m01; w.y = pk23 & m23; w.z = pk01 ^ w.x; w.w = pk23 ^ w.y;
                        pf[i] = __builtin_bit_cast(bf16x8, w); }
                    float lsum = lsum2.x + lsum2.y;
                    lsum += __shfl_xor(lsum, 16); lsum += __shfl_xor(lsum, 32);
                    f32x4 o[4];
#pragma unroll
                    for (int hb = 0; hb < 4; ++hb) o[hb] = (f32x4){0.f, 0.f, 0.f, 0.f};
                    const int qq = q >> 2, pp = lane & 3;
                    const int tokx = kcs + 4 * g4 + qq, toky = tokx + 16;
                    const int swx = ((tokx >> 1) & 3) << 1, swy = ((toky >> 1) & 3) << 1;
#pragma unroll
                    for (int i = 0; i < 8; ++i) { int slot = slot0 + i; slot = slot >= 9 ? slot - 9 : slot;
                        const LAS unsigned char* vbase = lds + VRING_OFF + slot * 8192;
#pragma unroll
                        for (int hb = 0; hb < 4; ++hb) { const int ch = 2 * hb + (pp >> 1);
                            const s16x4 vlo = __builtin_amdgcn_ds_read_tr16_b64_v4i16((LAS s16x4*)(vbase + tokx * 128 + ((ch ^ swx) * 16) + 8 * (pp & 1)));
                            const s16x4 vhi = __builtin_amdgcn_ds_read_tr16_b64_v4i16((LAS s16x4*)(vbase + toky * 128 + ((ch ^ swy) * 16) + 8 * (pp & 1)));
                            const bf16x8 vf = (bf16x8){vlo[0], vlo[1], vlo[2], vlo[3], vhi[0], vhi[1], vhi[2], vhi[3]};
                            o[hb] = __builtin_amdgcn_mfma_f32_16x16x32_bf16(vf, pf[i], o[hb], 0, 0, 0); } }
                    const float rl = 1.0f / (lsum * SC_KV8);
                    unsigned char* op = mix8 + tq * MIXP + h * 64 + 4 * g4; const float rla = rl * SC_A8;
#pragma unroll
                    for (int hb = 0; hb < 4; ++hb) *(unsigned*)(op + 16 * hb) = pk4_fp8(o[hb][0] * rla, o[hb][1] * rla, o[hb][2] * rla, o[hb][3] * rla);
                    if (do_pool) {
#pragma unroll
                        for (int tt = 0; tt < 2; ++tt) { const int t = ptb0 + 2 * s + tt; const int wlo = (t - phalf) < 0 ? 0 : (t - phalf), whi = (t + phalf) > SEQ ? SEQ : (t + phalf);
                            const float rc = 1.0f / (float)(whi - wlo), ma = (t + phalf < SEQ) ? 1.f : 0.f, ms = (t - phalf >= 0) ? -1.f : 0.f;
                            const u32x4 cw = pl_[tt][0], aw = pl_[tt][1], sw_ = pl_[tt][2];
                            const float cv[8] = {bf_lo(cw.x), bf_hi(cw.x), bf_lo(cw.y), bf_hi(cw.y), bf_lo(cw.z), bf_hi(cw.z), bf_lo(cw.w), bf_hi(cw.w)};
                            const float av[8] = {bf_lo(aw.x), bf_hi(aw.x), bf_lo(aw.y), bf_hi(aw.y), bf_lo(aw.z), bf_hi(aw.z), bf_lo(aw.w), bf_hi(aw.w)};
                            const float sv[8] = {bf_lo(sw_.x), bf_hi(sw_.x), bf_lo(sw_.y), bf_hi(sw_.y), bf_lo(sw_.z), bf_hi(sw_.z), bf_lo(sw_.w), bf_hi(sw_.w)};
                            float o_[8];
#pragma unroll
                            for (int c = 0; c < 8; ++c) { o_[c] = psum[c] * rc - cv[c]; psum[c] += ma * av[c] + ms * sv[c]; }
                            u32x4 w; w.x = cvt_pk_bf16(o_[0], o_[1]); w.y = cvt_pk_bf16(o_[2], o_[3]); w.z = cvt_pk_bf16(o_[4], o_[5]); w.w = cvt_pk_bf16(o_[6], o_[7]);
                            *(u32x4*)(pob + (size_t)t * MIXP) = w; } }
                    __syncthreads();
#pragma unroll
                    for (int j = 0; j < 2; ++j) if (j < nnew) { const int kr = hi_loaded + 1 + j; const int sl = kr % 9; RING_PUT(sl, pk_[j]); }
                    hi_loaded = next_hi;
                    __syncthreads();
                }
            }
            {
                const int half = 1 << (lane >> 4);
                for (int rg = bx * NWAVES + wave + (pooled_inline ? G * NWAVES : 0); rg < T / 32; rg += G * NWAVES) {
                    const int t0 = rg * 32, bb = t0 / SEQ, tb0 = t0 % SEQ;
                    const bf16* ub = proj + (size_t)bb * SEQ * DIN + 1536 + lane * 8;
                    unsigned char* ob = mix8 + (size_t)bb * SEQ * MIXP + 512 + lane * 16;
                    float sum[8];
#pragma unroll
                    for (int c = 0; c < 8; ++c) sum[c] = 0.f;
                    for (int d = -8; d < 8; ++d) { const int j = tb0 + d; if (d >= -half && d < half && j >= 0 && j < SEQ) { const u32x4 w = *(const u32x4*)(ub + (size_t)j * DIN);
                            sum[0] += bf_lo(w.x); sum[1] += bf_hi(w.x); sum[2] += bf_lo(w.y); sum[3] += bf_hi(w.y); sum[4] += bf_lo(w.z); sum[5] += bf_hi(w.z); sum[6] += bf_lo(w.w); sum[7] += bf_hi(w.w); } }
#pragma unroll 4
                    for (int tt = 0; tt < 32; ++tt) { const int t = tb0 + tt; const int wlo = (t - half) < 0 ? 0 : (t - half), whi = (t + half) > SEQ ? SEQ : (t + half);
                        const float rc = 1.0f / (float)(whi - wlo);
                        const u32x4 cw = *(const u32x4*)(ub + (size_t)t * DIN);
                        float o_[8]; const float cv[8] = {bf_lo(cw.x), bf_hi(cw.x), bf_lo(cw.y), bf_hi(cw.y), bf_lo(cw.z), bf_hi(cw.z), bf_lo(cw.w), bf_hi(cw.w)};
#pragma unroll
                        for (int c = 0; c < 8; ++c) o_[c] = sum[c] * rc - cv[c];
                        u32x4 w; w.x = cvt_pk_bf16(o_[0], o_[1]); w.y = cvt_pk_bf16(o_[2], o_[3]); w.z = cvt_pk_bf16(o_[4], o_[5]); w.w = cvt_pk_bf16(o_[6], o_[7]);
                        *(u32x4*)(ob + (size_t)t * MIXP) = w;
                        if (t + half < SEQ) { const u32x4 a = *(const u32x4*)(ub + (size_t)(t + half) * DIN);
                            sum[0] += bf_lo(a.x); sum[1] += bf_hi(a.x); sum[2] += bf_lo(a.y); sum[3] += bf_hi(a.y); sum[4] += bf_lo(a.z); sum[5] += bf_hi(a.z); sum[6] += bf_lo(a.w); sum[7] += bf_hi(a.w); }
                        if (t - half >= 0) { const u32x4 a = *(const u32x4*)(ub + (size_t)(t - half) * DIN);
                            sum[0] -= bf_lo(a.x); sum[1] -= bf_hi(a.x); sum[2] -= bf_lo(a.y); sum[3] -= bf_hi(a.y); sum[4] -= bf_lo(a.z); sum[5] -= bf_hi(a.z); sum[6] -= bf_lo(a.w); sum[7] -= bf_hi(a.w); }
                    }
                }
            }
            __syncthreads();
        }
        SEAM(pb + 1);
        if (IN(pb + 2)) for (int rep_ = 0; rep_ < (l == 0 ? REP_P3L0 : 1); ++rep_) {
        WS_PTRS();
            pg8::Gemm g{MIXP / 2, MIXP / 2, MIXP / 2, 1 << 20, (unsigned)(128 * MIXP), nullptr, 4};
            pg8::StaticOrder S; S.init(mix8, Wout8 + (size_t)l * D * MIXP, MIXP / 2, MIXP / 2, T, D, G, opaque_s(bx), 1);
            pg8::EpiRes E{xb, x8};
            pg8::gemm_phase<pg8::EpiRes, pg8::StaticOrder, false, 2, false, 2>(lds, wave_s, g, S, E);
        }
        SEAM(pb + 2);
        if (IN(pb + 3)) {
        WS_PTRS();
        PHASE_IDS();
            volatile LAS int* cntl = (volatile LAS int*)(MISC + MW_CNTL); volatile LAS int* basel = (volatile LAS int*)(MISC + MW_BASEL);
            { const u32x4* src = rfrag + (size_t)l * 8192; for (int i = tid; i < 8192; i += NTHREADS) ((LAS u32x4*)lds)[i] = src[i]; }
            gu32* gcnt = ctl + CW_CNT + 32 * l;
            for (int it = 0;; ++it) {
                const int tile0 = (it * G + bx) * NWAVES; if (tile0 >= T / 32) break;
                if (tid < NBUCKET) cntl[tid] = 0;
                __syncthreads();
                const int tile = tile0 + wave, tokn = tile * 32 + (lane & 31), kg = lane >> 5;
                const u32x4* xr = (const u32x4*)(xb + (size_t)tokn * D + kg * 32);
                f32x16 acc;
#pragma unroll
                for (int i = 0; i < 16; ++i) acc[i] = 0.f;
                float ss = 0.f;
#pragma unroll 4
                for (int G4 = 0; G4 < 16; ++G4) { u32x4 v[4];
#pragma unroll
                    for (int j = 0; j < 4; ++j) v[j] = xr[G4 * 8 + j];
#pragma unroll
                    for (int s4 = 0; s4 < 4; ++s4) { const u32x4 hw = v[s4];
                        const float f0 = bf_lo(hw.x), f1 = bf_hi(hw.x), f2 = bf_lo(hw.y), f3 = bf_hi(hw.y), f4 = bf_lo(hw.z), f5 = bf_hi(hw.z), f6 = bf_lo(hw.w), f7 = bf_hi(hw.w);
                        ss += ((f0 * f0 + f1 * f1) + (f2 * f2 + f3 * f3)) + ((f4 * f4 + f5 * f5) + (f6 * f6 + f7 * f7));
                        const int step = G4 * 4 + s4;
                        const bf16x8 ah = *(const LAS bf16x8*)(lds + ((0 * 64 + step) * 64 + lane) * 16), al = *(const LAS bf16x8*)(lds + ((1 * 64 + step) * 64 + lane) * 16);
                        const bf16x8 bh_ = __builtin_bit_cast(bf16x8, hw);
                        acc = __builtin_amdgcn_mfma_f32_32x32x16_bf16(ah, bh_, acc, 0, 0, 0);
                        acc = __builtin_amdgcn_mfma_f32_32x32x16_bf16(al, bh_, acc, 0, 0, 0); } }
                ss += __shfl_xor(ss, 32);
                const float rs = __builtin_amdgcn_rsqf(ss * (1.0f / D) + EPS);
                const float g0 = acc[0] * rs, g1 = acc[1] * rs, g2 = acc[2] * rs, g3 = acc[3] * rs;
                int gi = 0; float gb = g0; if (g1 > gb) { gb = g1; gi = 1; } if (g2 > gb) { gb = g2; gi = 2; } if (g3 > gb) { gb = g3; gi = 3; }
                const float gsum = fast_exp2((g0 - gb) * LOG2E) + fast_exp2((g1 - gb) * LOG2E) + fast_exp2((g2 - gb) * LOG2E) + fast_exp2((g3 - gb) * LOG2E);
                const float gwt = 1.0f / gsum;
                const bool hiq = (gi >> 1) != 0;
                const float e0 = (hiq ? acc[8] : acc[4]) * rs, e1 = (hiq ? acc[9] : acc[5]) * rs, e2 = (hiq ? acc[10] : acc[6]) * rs, e3 = (hiq ? acc[11] : acc[7]) * rs;
                int i1 = 0; float v1 = e0; if (e1 > v1) { v1 = e1; i1 = 1; } if (e2 > v1) { v1 = e2; i1 = 2; } if (e3 > v1) { v1 = e3; i1 = 3; }
                int i2 = (i1 == 0) ? 1 : 0; float v2 = (i1 == 0) ? e1 : e0;
                if (i1 != 1 && i2 != 1 && e1 > v2) { v2 = e1; i2 = 1; }
                if (i1 != 2 && e2 > v2) { v2 = e2; i2 = 2; }
                if (i1 != 3 && e3 > v2) { v2 = e3; i2 = 3; }
                const float w1 = gwt / (1.0f + fast_exp2((v2 - v1) * LOG2E)), w2 = gwt - w1;
                const int ea = i1 < i2 ? i1 : i2, eb = i1 < i2 ? i2 : i1; const float wa = i1 < i2 ? w1 : w2, wb = i1 < i2 ? w2 : w1;
                const int bucket = gi * 6 + (ea == 0 ? 0 : (ea == 1 ? 3 : 5)) + (eb - ea - 1);
                const bool owner = (kg == (gi & 1));
                int rank = 0;
                if (owner) rank = __hip_atomic_fetch_add((LAS int*)(MISC + MW_CNTL) + bucket, 1, __ATOMIC_RELAXED, __HIP_MEMORY_SCOPE_WORKGROUP);
                __syncthreads();
                if (tid < NBUCKET) { const int c = cntl[tid]; basel[tid] = c ? (int)__hip_atomic_fetch_add(gcnt + tid, (unsigned)c, RLX_AGENT) : 0; }
                __syncthreads();
                if (owner) { u32x4 e; e.x = (unsigned)tokn; e.y = __float_as_uint(rs * (1.0f / (SC_X8 * SC_WGU))); e.z = __float_as_uint(wa * SC_H8); e.w = __float_as_uint(wb * SC_H8);
                    list[(size_t)bucket * T + basel[bucket] + rank] = e; }
            }
            __syncthreads();
        }
        SEAM(pb + 3);
        if (IN(pb + 4) || IN(pb + 5)) {
        PHASE_IDS();
            volatile LAS int* tb = (volatile LAS int*)(MISC + MW_TB); volatile LAS int* cnt2 = (volatile LAS int*)(MISC + MW_CNT2);
            __syncthreads();
            if (tid == 0) { int a = 0;
#pragma nounroll
                for (int k = 0; k < NBUCKET; ++k) { const int c = (int)__hip_atomic_load(ctl + CW_CNT + 32 * l + k, RLX_AGENT); cnt2[k] = c; tb[k] = a; a += (c + 255) >> 8; } tb[NBUCKET] = a; }
            __syncthreads();
        }
        if (IN(pb + 4)) for (int rep_ = 0; rep_ < REP_P5; ++rep_) {
        WS_PTRS();
            const volatile LAS int* tb = (const volatile LAS int*)(MISC + MW_TB);
            pg8::Gemm g{D / 2, D / 2, D / 2, 1 << 20, (unsigned)(512 * D), nullptr};
            MoeOrder<8> S{tb, (const volatile LAS int*)(MISC + MW_CNT2), tb[NBUCKET] * 8, G, opaque_s(vcu), (const char*)x8, (const char*)(Wgu8 + (size_t)l * NE * 1024 * D), list};
            pg8::EpiSwiglu E{H8};
            pg8::gemm_phase<pg8::EpiSwiglu, MoeOrder<8>, true, 1, false, true>(lds, wave_s, g, S, E);
        }
        SEAM(pb + 4);
        if (IN(pb + 5)) {
        WS_PTRS();
            const volatile LAS int* tb = (const volatile LAS int*)(MISC + MW_TB);
            pg8::Gemm g{D / 2, DE / 2, D / 2, 4, (unsigned)(128 * DE), nullptr};
            MoeOrder<4> S{tb, (const volatile LAS int*)(MISC + MW_CNT2), tb[NBUCKET] * 4, G, opaque_s(vcu), (const char*)H8, (const char*)(Wd8 + (size_t)l * NE * 1024 * DE), list};
            pg8::EpiScatter E{xb, ssq, x8};
            pg8::gemm_phase<pg8::EpiScatter, MoeOrder<4>, true, 2, true, true>(lds, wave_s, g, S, E);
            if (l + 1 < DEPTH) {
                const int rem = S.nunits % G; const bool slack = rem != 0 && S.c >= rem;
                if (rem == 0 || slack) { PHASE_IDS(); LAS float* scr = (LAS float*)(lds + wave * 16384);
                    const int gwx = (rem == 0 ? S.c : S.c - rem) * NWAVES + wave, ngwx = (rem == 0 ? G : G - rem) * NWAVES;
                    CONVERT_WEIGHTS(l + 1, l + 2, gwx, ngwx) } }
        }
        SEAM(pb + 5);
    }
    if (IN(N_PHASES - 1)) {
        PHASE_IDS();
        WS_PTRS();
        const f32x4* gp8 = (const f32x4*)final_g;
        for (int m0 = gw * 4; m0 < T; m0 += NGW * 4) {
            u32x4 v[4][2];
#pragma unroll
            for (int rr = 0; rr < 4; ++rr)
#pragma unroll
                for (int j = 0; j < 2; ++j) v[rr][j] = ((const u32x4*)(xb + (size_t)(m0 + rr) * D))[lane + 64 * j];
#pragma unroll
            for (int rr = 0; rr < 4; ++rr) { float f[2][8]; float s = 0.f;
#pragma unroll
                for (int j = 0; j < 2; ++j) { const u32x4 w = v[rr][j]; f[j][0] = bf_lo(w.x); f[j][1] = bf_hi(w.x); f[j][2] = bf_lo(w.y); f[j][3] = bf_hi(w.y); f[j][4] = bf_lo(w.z); f[j][5] = bf_hi(w.z); f[j][6] = bf_lo(w.w); f[j][7] = bf_hi(w.w);
#pragma unroll
                    for (int c = 0; c < 8; ++c) s += f[j][c] * f[j][c]; }
                s = wave_sum(s); const float rs = 1.0f / sqrtf(s * (1.0f / D) + EPS);
                float* orow = args.out + (size_t)(m0 + rr) * D;
#pragma unroll
                for (int j = 0; j < 2; ++j) { const f32x4 ga = gp8[(lane + 64 * j) * 2], gb = gp8[(lane + 64 * j) * 2 + 1];
                    *(f32x4*)(orow + 8 * (lane + 64 * j)) = (f32x4){f[j][0], f[j][1], f[j][2], f[j][3]} * rs * ga;
                    *(f32x4*)(orow + 8 * (lane + 64 * j) + 4) = (f32x4){f[j][4], f[j][5], f[j][6], f[j][7]} * rs * gb; } }
        }
    }
#undef IN
#undef SEAM
#undef PHASE_IDS
#undef RING_PUT
#undef WS_PTRS
}

extern "C" void kernel_launch(void* const* d_in, const int* in_sizes, int n_in, void* d_out, int out_size, void* d_ws, size_t ws_size, hipStream_t stream) {
    static int grid = 0;
    if (grid == 0) {
        if (n_in != 14 || in_sizes[0] != T * D || out_size != T * D || ws_size < WS_END) { fprintf(stderr, "kernel_launch: unexpected shapes / workspace (n_in %d, ws %zu)\n", n_in, ws_size); grid = -1; return; }
        int dev = 0, cus = 0, per_cu = 0;
        if (hipGetDevice(&dev) != hipSuccess || hipDeviceGetAttribute(&cus, hipDeviceAttributeMultiprocessorCount, dev) != hipSuccess) { grid = -1; return; }
        if (hipFuncSetAttribute((const void*)enc_fwd, hipFuncAttributeMaxDynamicSharedMemorySize, LDS_BYTES) != hipSuccess) { fprintf(stderr, "kernel_launch: hipFuncSetAttribute failed\n"); grid = -1; return; }
        if (hipOccupancyMaxActiveBlocksPerMultiprocessor(&per_cu, (const void*)enc_fwd, NTHREADS, LDS_BYTES) != hipSuccess || per_cu < 1) { fprintf(stderr, "kernel_launch: occupancy query reports %d\n", per_cu); }
        (void)hipGetLastError();
        grid = cus;
    }
    if (grid < 0) return;
    (void)hipMemsetAsync((char*)d_ws + WS_CTL, 0, CTL_ZERO_BYTES, stream);
    Args a{};
    for (int i = 0; i < 14; ++i) a.in[i] = (const float*)d_in[i];
    a.out = (float*)d_out; a.ws = (unsigned char*)d_ws; a.pad = 0;
    if (MK_N_LAUNCHES == 1) {
        a.ph_lo = 0; a.ph_hi = N_PHASES; a.li = 0;
        hipLaunchKernelGGL(enc_fwd, dim3(grid), dim3(NTHREADS), LDS_BYTES, stream, a);
    } else {
        for (int p = 0; p < N_PHASES; ++p) { a.ph_lo = p; a.ph_hi = p + 1; a.li = p; hipLaunchKernelGGL(enc_fwd, dim3(grid), dim3(NTHREADS), LDS_BYTES, stream, a); }
    }
}
```

```cpp
#include <hip/hip_runtime.h>
#include <cstdio>
#include <cstdint>

#define REP_P0 1
#define REP_P1 1
#define REP_P2 1
#define REP_P3L0 1
#define REP_P5 1
#ifndef MK_N_LAUNCHES
#define MK_N_LAUNCHES 1
#endif

#define GAS __attribute__((address_space(1)))
#define LAS __attribute__((address_space(3)))
typedef unsigned short bf16;
typedef short bf16x8 __attribute__((ext_vector_type(8)));
typedef short s16x4 __attribute__((ext_vector_type(4)));
typedef float f32x4 __attribute__((ext_vector_type(4)));
typedef float f32x2 __attribute__((ext_vector_type(2)));
typedef float f32x16 __attribute__((ext_vector_type(16)));
typedef unsigned u32x4 __attribute__((ext_vector_type(4)));
typedef unsigned u32x2 __attribute__((ext_vector_type(2)));
typedef GAS unsigned gu32;

constexpr int D = 1024, BATCH = 32, SEQ = 2048, T = BATCH * SEQ, DEPTH = 4;
constexpr int DIN = 2048, NH = 8, HD = 64, GRIDW = 64, ROWS = SEQ / GRIDW;
constexpr int NE = 16, DE = 512, NBUCKET = 24;
constexpr float EPS = 1e-6f, LOG2E = 1.4426950408889634f;
constexpr int NWAVES = 8, NTHREADS = 512;

constexpr size_t MiB = 1u << 20;
constexpr size_t WS_CTL = 0, CTL_ZERO_BYTES = 1 * MiB;
constexpr size_t WS_WIN = 2 * MiB;
constexpr size_t WS_WOUT = 18 * MiB;
constexpr size_t WS_WGU = 26 * MiB;
constexpr size_t WS_WD = 154 * MiB;
constexpr size_t WS_RFRAG = 218 * MiB;
constexpr size_t WS_SSQ = 219 * MiB;
constexpr size_t WS_LIST = 223 * MiB;
constexpr size_t WS_XB = 248 * MiB;
constexpr size_t WS_PROJ = 376 * MiB;
constexpr size_t WS_H = WS_PROJ;
constexpr size_t WS_MIX = 632 * MiB;
constexpr size_t WS_X8 = 760 * MiB;
constexpr size_t WS_WIN8 = 824 * MiB;
constexpr size_t WS_QKV8 = 832 * MiB;
constexpr size_t WS_END = 928 * MiB;
constexpr float SC_Q8 = 16.0f, SC_KV8 = 4.0f, SC_A8 = 16.0f;
constexpr int MIXP = 1536;
constexpr float SC_X8 = 4.0f, SC_WGU = 64.0f, SC_H8 = 16.0f, SC_WD = 128.0f;
constexpr int MAXTILES = T / 256 + NBUCKET;
static_assert((size_t)MAXTILES * 256 * 1024 * 2 <= 256 * MiB, "H fits the proj overlay");
constexpr int CW_TMO = 0, CW_CODE = 1, CW_BAR = 4096, CW_CNT = 8192;

constexpr int RING_BYTES = 131072;
constexpr int KRING_OFF = 0, VRING_OFF = 73728, ATT_RING_END = 147456;
constexpr int BIAS_OFF = ATT_RING_END;
constexpr int MISC_OFF = BIAS_OFF + 2048;
constexpr int LDS_BYTES = MISC_OFF + 512;
constexpr int MW_BAR = 0, MW_CNTL = 4, MW_BASEL = 32, MW_TB = 64, MW_CNT2 = 96;

#define RLX_AGENT __ATOMIC_RELAXED, __HIP_MEMORY_SCOPE_AGENT
#define LDS_WAIT() asm volatile("s_waitcnt lgkmcnt(0)" ::: "memory")
#define VM_WAIT() asm volatile("s_waitcnt vmcnt(0)" ::: "memory")
__device__ __forceinline__ unsigned f2bf(float f) { unsigned u = __builtin_bit_cast(unsigned, f); return (u + 0x7fffu + ((u >> 16) & 1u)) >> 16; }
__device__ __forceinline__ unsigned pk2(float lo, float hi) { return f2bf(lo) | (f2bf(hi) << 16); }
__device__ __forceinline__ unsigned cvt_pk_bf16(float lo, float hi) { unsigned r; asm volatile("v_cvt_pk_bf16_f32 %0, %1, %2" : "=v"(r) : "v"(lo), "v"(hi)); return r; }
__device__ __forceinline__ float bf_lo(unsigned w) { return __builtin_bit_cast(float, w << 16); }
__device__ __forceinline__ float bf_hi(unsigned w) { return __builtin_bit_cast(float, w & 0xffff0000u); }
__device__ __forceinline__ int lane_id() { int r; asm volatile("v_mbcnt_lo_u32_b32 %0, -1, 0\n\tv_mbcnt_hi_u32_b32 %0, -1, %0" : "=v"(r)); return r; }
template <class P> __device__ __forceinline__ P* opaque_p(P* p) { asm volatile("" : "+s"(p)); return p; }
__device__ __forceinline__ int opaque_s(int v) { asm volatile("" : "+s"(v)); return v; }
__device__ __forceinline__ int opaque(int v) { asm volatile("" : "+v"(v)); return v; }
__device__ __forceinline__ unsigned pk4_fp8(float a, float b, float c, float d) {
    int w = 0; w = __builtin_amdgcn_cvt_pk_fp8_f32(a, b, w, false); w = __builtin_amdgcn_cvt_pk_fp8_f32(c, d, w, true); return (unsigned)w; }
typedef float f32x2v __attribute__((ext_vector_type(2)));
__device__ __forceinline__ u32x2 fp8x4_to_bf16x4(unsigned w, float s) {
    const f32x2v a = __builtin_amdgcn_cvt_pk_f32_fp8((int)w, false), b = __builtin_amdgcn_cvt_pk_f32_fp8((int)w, true);
    u32x2 r; r.x = cvt_pk_bf16(a[0] * s, a[1] * s); r.y = cvt_pk_bf16(b[0] * s, b[1] * s); return r; }
__device__ __forceinline__ float max3f(float a, float b, float c) { float r; asm("v_max3_f32 %0, %1, %2, %3" : "=v"(r) : "v"(a), "v"(b), "v"(c)); return r; }
__device__ __forceinline__ float fast_exp2(float x) { return __builtin_amdgcn_exp2f(x); }
__device__ __forceinline__ float fast_rcp(float x) { return __builtin_amdgcn_rcpf(x); }

#define XB_TMO      128
#define XB_XCNT(j)  (256  + 64 * (j))
#define XB_XSUB(j)  (1280 + 64 * (j))
#define XB_XGEN(j)  (2304 + 64 * (j))
#define XB_TOP      3328
#define XB_TOPGEN   3392
#define XCD_BAR_WORDS 3456
#define XB_SPIN_CAP (1u << 22)
__device__ __forceinline__ unsigned xb_ld(unsigned* p)              { return __hip_atomic_load(p, __ATOMIC_RELAXED, __HIP_MEMORY_SCOPE_AGENT); }
__device__ __forceinline__ unsigned xb_add(unsigned* p, unsigned v) { return __hip_atomic_fetch_add(p, v, __ATOMIC_RELAXED, __HIP_MEMORY_SCOPE_AGENT); }
__device__ __forceinline__ unsigned xb_xcc_id() { return (unsigned)__builtin_amdgcn_s_getreg((3 << 11) | 20) & 0xFu; }
#define XB_SPIN(cond, bar) do { unsigned _sp = 0; while (cond) { __builtin_amdgcn_s_sleep(1); \
    if ((++_sp & 255u) == 0u) { if (xb_ld(&(bar)[XB_TMO])) break; if (_sp > XB_SPIN_CAP) { atomicAdd(&(bar)[XB_TMO], 1u); break; } } } } while (0)
struct XcdBarrier { unsigned* bar; unsigned x; volatile LAS unsigned* st; };
__device__ __forceinline__ XcdBarrier xcd_barrier_post(unsigned* bar, volatile LAS unsigned* st) {
    XcdBarrier b; b.bar = bar; b.x = xb_xcc_id(); b.st = st;
    if (threadIdx.x == 0) (void)xb_add(&bar[XB_XCNT(b.x)], 1u);
    return b;
}
__device__ __forceinline__ void xcd_barrier_complete(unsigned* bar, unsigned x, unsigned& nloc, unsigned& nx) {
    const unsigned G = gridDim.x * gridDim.y * gridDim.z;
    unsigned sum, cnt, mine, sp = 0u;
    for (;;) {
        sum = 0u; cnt = 0u; mine = 0u;
#pragma nounroll
        for (unsigned j = 0; j < 16; ++j) { const unsigned c = xb_ld(&bar[XB_XCNT(j)]); sum += c; cnt += (c > 0u) ? 1u : 0u; mine = (j == x) ? c : mine; }
        if (sum == G) break;
        __builtin_amdgcn_s_sleep(1);
        if ((++sp & 255u) == 0u) { if (xb_ld(&bar[XB_TMO])) break; if (sp > XB_SPIN_CAP) { atomicAdd(&bar[XB_TMO], 1u); break; } }
    }
    nloc = mine > 0u ? mine : 1u; nx = cnt > 0u ? cnt : 1u;
}
__device__ __forceinline__ void xcd_barrier(const XcdBarrier& b, const bool leader) {
    asm volatile("s_waitcnt vmcnt(0)" ::: "memory");
    __syncthreads();
    if (leader) {
        unsigned* bar = b.bar;
        __builtin_amdgcn_s_waitcnt(0);
        unsigned nloc = b.st[0], nx = b.st[1];
        if (nloc == 0u) { xcd_barrier_complete(bar, b.x, nloc, nx); b.st[0] = nloc; b.st[1] = nx; }
        const unsigned old = xb_add(&bar[XB_XSUB(b.x)], 1u);
        const unsigned gen = old / nloc;
        if (old + 1u == (gen + 1u) * nloc) {
            __builtin_amdgcn_fence(__ATOMIC_RELEASE, "agent");
            asm volatile("s_waitcnt vmcnt(0)" ::: "memory");
            const unsigned og = xb_add(&bar[XB_TOP], 1u);
            const unsigned tg = og / nx;
            if (og + 1u == (tg + 1u) * nx) xb_add(&bar[XB_TOPGEN], 1u);
            else XB_SPIN(xb_ld(&bar[XB_TOPGEN]) == tg, bar);
            __builtin_amdgcn_fence(__ATOMIC_ACQUIRE, "agent");
            xb_add(&bar[XB_XGEN(b.x)], 1u);
            asm volatile("s_waitcnt vmcnt(0)" ::: "memory");
        } else {
            XB_SPIN(xb_ld(&bar[XB_XGEN(b.x)]) == gen, bar);
            __builtin_amdgcn_fence(__ATOMIC_ACQUIRE, "agent");
            asm volatile("s_waitcnt vmcnt(0)" ::: "memory");
        }
    }
    __syncthreads();
}

__device__ __forceinline__ void glds16(const char* sbase, unsigned voff, unsigned lds_dst) { unsigned keep;
    asm volatile("s_mov_b32 %0, m0\n\ts_mov_b32 m0, %3\n\ts_nop 0\n\tglobal_load_lds_dwordx4 %1, %2\n\ts_mov_b32 m0, %0" : "=&s"(keep) : "v"(voff), "s"(sbase), "s"(lds_dst) : "memory"); }

namespace pg8 {
constexpr int BM = 256, BK = 64, HALF = 128, HTB = HALF * BK * 2, STAGE_BYTES = 8 * HTB, NXCD = 8, WGM = 8;
__host__ __device__ __forceinline__ int lds_byte(int r, int c) { const int st = (r >> 4) * 2 + (c >> 5), rr = r & 15, cc = c & 31, ob = rr * 64 + cc * 2; return st * 1024 + (ob ^ (((ob >> 9) & 1) << 5)); }
__host__ __device__ __forceinline__ void stage_rc(int b, int& R, int& C) { const int st = b / 1024, sb = b % 1024, swz = sb ^ (((sb >> 9) & 1) << 5); R = (st >> 1) * 16 + swz / 64; C = (st & 1) * 32 + (swz % 64) / 2; }
__host__ __device__ __forceinline__ int perm32(int rho) { const int n = rho >> 4, i = rho & 15; return 8 * (i >> 2) + 4 * n + (i & 3); }

struct Unit {
    const char* A;
    const char* B;
    const char* B2;
    const u32x4* rows;
    int nvalid, pm, pn, tile, sub;
};
struct Gemm { int lda, ldb, K, ksplit; unsigned hstepB; const char* aux; int mixk; };

struct StaticOrder {
    const char* A; const char* Bt; int lda, ldb;
    int nM, nN, nwg, G, c, abase;
    __device__ void init(const void* A_, const void* Bt_, int lda_, int ldb_, int M, int N, int G_, int c_, int abase_) { A = (const char*)A_; Bt = (const char*)Bt_; lda = lda_; ldb = ldb_; nM = M / BM; nN = N / BM; nwg = nM * nN; G = G_; c = c_; abase = abase_; }
    __device__ bool next(int i, Unit& u) const {
        const int L = i * G + c; if (L >= nwg) return false;
        int wgid = L; { const int q = nwg / NXCD, r = nwg % NXCD, xcd = wgid % NXCD, off = wgid / NXCD; wgid = (xcd < r ? xcd * (q + 1) : r * (q + 1) + (xcd - r) * q) + off; }
        const int nig = WGM * nN, gid = wgid / nig, fm = gid * WGM, gsz = (nM - fm) < WGM ? (nM - fm) : WGM;
        u.pm = fm + ((wgid % nig) % gsz); u.pn = (wgid % nig) / gsz;
        u.A = abase ? A : A + (size_t)u.pm * BM * lda * 2; u.B = Bt + (size_t)u.pn * BM * ldb * 2; u.B2 = u.B; u.rows = nullptr; u.nvalid = BM; u.tile = u.pm; u.sub = u.pn;
        return true;
    }
};

constexpr int ETAB_OFF = 131072, ETAB_BYTES = 4096;
typedef int i32x8 __attribute__((ext_vector_type(8)));
typedef int i32x4v __attribute__((ext_vector_type(4)));
template <class Epi, class Sched, bool ETAB, int GATHER, bool SPLITK, int FP8, bool SSQP = false>
__device__ __forceinline__ void gemm_phase(LAS unsigned char* lds, const int wid_in, const Gemm g, const Sched& S, const Epi& E) {
    const int wid = opaque_s(wid_in);
    const int lane = lane_id(), tid = wid * 64 + lane, wr = wid >> 2, wc = wid & 3, fr = lane & 15, fq = lane >> 4;
    const int nt = opaque_s(g.K / BK);
    unsigned cvA[2][2], voffB[2];
#pragma unroll
    for (int i = 0; i < 2; ++i) { int R, C; stage_rc(tid * 16 + i * 8192, R, C); const int Rb = Epi::PERM ? ((R & ~31) + perm32(R & 31)) : R;
        voffB[i] = (unsigned)(Rb * g.ldb + C) * 2u;
#pragma unroll
        for (int h = 0; h < 2; ++h) cvA[h][i] = (unsigned)((R + h * HALF) * g.lda + C) * 2u; }
    const size_t kstep = (size_t)(BK * 2);
    const size_t hstepB = g.hstepB;
    const unsigned ldsw = (unsigned)wid * 1024u, ldsb = (unsigned)(size_t)lds;
    const int aoff = lds_byte(wr * 64 + fr, fq * 8), boff = lds_byte(wc * 32 + fr, fq * 8);
#define PG8_SA(b, h) (((b) * 2 + (h)) * HTB)
#define PG8_SB(b, h) ((4 + (b) * 2 + (h)) * HTB)
#define PG8_STAGE(bufoff, gbase, v0, v1) do { glds16((const char*)(gbase), (v0), ldsb + (unsigned)(bufoff) + ldsw); glds16((const char*)(gbase), (v1), ldsb + (unsigned)(bufoff) + ldsw + 8192u); } while (0)
#define PG8_LD16(off) (*(const LAS i32x4v*)(lds + (off)))
#define PG8_LDA(dst, b, h) do { if constexpr (FP8 != 0) { _Pragma("unroll") for (int m = 0; m < 4; ++m) dst##8[m] = __builtin_shufflevector(PG8_LD16(PG8_SA(b, h) + aoff + m * 2048), PG8_LD16(PG8_SA(b, h) + aoff + m * 2048 + 1024), 0, 1, 2, 3, 4, 5, 6, 7); } \
        else { _Pragma("unroll") for (int m = 0; m < 4; ++m) _Pragma("unroll") for (int k = 0; k < 2; ++k) dst[m][k] = *(const LAS bf16x8*)(lds + PG8_SA(b, h) + aoff + m * 2048 + k * 1024); } } while (0)
#define PG8_LDB(dst, b, h) do { if constexpr (FP8 != 0) { _Pragma("unroll") for (int n = 0; n < 2; ++n) dst##8[n] = __builtin_shufflevector(PG8_LD16(PG8_SB(b, h) + boff + n * 2048), PG8_LD16(PG8_SB(b, h) + boff + n * 2048 + 1024), 0, 1, 2, 3, 4, 5, 6, 7); } \
        else { _Pragma("unroll") for (int n = 0; n < 2; ++n) _Pragma("unroll") for (int k = 0; k < 2; ++k) dst[n][k] = *(const LAS bf16x8*)(lds + PG8_SB(b, h) + boff + n * 2048 + k * 1024); } } while (0)
#define PG8_H0(x) __builtin_bit_cast(bf16x8, __builtin_shufflevector(x, x, 0, 1, 2, 3))
#define PG8_H1(x) __builtin_bit_cast(bf16x8, __builtin_shufflevector(x, x, 4, 5, 6, 7))
#define PG8_MMA(ai, bj, At, Bt, F8_) do { __builtin_amdgcn_s_setprio(1); \
        if constexpr ((F8_) == 1) { _Pragma("unroll") for (int m = 0; m < 4; ++m) _Pragma("unroll") for (int n = 0; n < 2; ++n) \
            acc[ai][bj][m][n] = __builtin_amdgcn_mfma_scale_f32_16x16x128_f8f6f4(Bt##8[n], At##8[m], acc[ai][bj][m][n], 0, 0, 0, 0, 0, 0); } \
        else if constexpr (FP8 != 0) { _Pragma("unroll") for (int m = 0; m < 4; ++m) _Pragma("unroll") for (int n = 0; n < 2; ++n) { \
            acc[ai][bj][m][n] = __builtin_amdgcn_mfma_f32_16x16x32_bf16(PG8_H0(Bt##8[n]), PG8_H0(At##8[m]), acc[ai][bj][m][n], 0, 0, 0); \
            acc[ai][bj][m][n] = __builtin_amdgcn_mfma_f32_16x16x32_bf16(PG8_H1(Bt##8[n]), PG8_H1(At##8[m]), acc[ai][bj][m][n], 0, 0, 0); } } \
        else { _Pragma("unroll") for (int m = 0; m < 4; ++m) _Pragma("unroll") for (int n = 0; n < 2; ++n) _Pragma("unroll") for (int k = 0; k < 2; ++k) \
            acc[ai][bj][m][n] = __builtin_amdgcn_mfma_f32_16x16x32_bf16(Bt[n % (FP8 != 0 ? 1 : 2)][k], At[m % (FP8 != 0 ? 1 : 4)][k], acc[ai][bj][m][n], 0, 0, 0); } __builtin_amdgcn_s_setprio(0); } while (0)
#define PG8_WAIT_V(n) asm volatile("s_waitcnt vmcnt(" #n ")" ::: "memory")
#define PG8_WAIT_L(n) asm volatile("s_waitcnt lgkmcnt(" #n ")" ::: "memory")
#define PG8_BAR __builtin_amdgcn_s_barrier()
#define PG8_SCHED __builtin_amdgcn_sched_barrier(0)
#define PG8_ETAB_DMA(U, BUF) do { if (wid < 4) { int e_ = wid * 64 + lane; e_ = e_ < (U).nvalid ? e_ : (U).nvalid - 1; \
        glds16((const char*)(U).rows, (unsigned)e_ * 16u, ldsb + (unsigned)(ETAB_OFF + (BUF) * ETAB_BYTES) + ldsw); } } while (0)
#define PG8_GATHER_HALF(H, BUF, U) do { const int t2_ = wid * 64 + opaque(lane); _Pragma("unroll") for (int i = 0; i < 2; ++i) { int R_, C_; stage_rc(t2_ * 16 + i * 8192, R_, C_); \
        const unsigned tok_ = GATHER == 2 ? (unsigned)((U).tile * BM + R_ + (H) * HALF) : *(const LAS unsigned*)(lds + ETAB_OFF + (BUF) * ETAB_BYTES + (R_ + (H) * HALF) * 16); cvA[H][i] = (tok_ * (unsigned)g.lda + (unsigned)C_) * 2u; } } while (0)
    Unit cur, nxt; int ui = 0;
    if (!S.next(0, cur)) return;
    f32x4 acc[2][2][4][2];
#pragma unroll
    for (int a = 0; a < 2; ++a)
#pragma unroll
        for (int b = 0; b < 2; ++b)
#pragma unroll
            for (int m = 0; m < 4; ++m)
#pragma unroll
                for (int n = 0; n < 2; ++n) acc[a][b][m][n] = (f32x4){0.f, 0.f, 0.f, 0.f};
    bf16x8 At[FP8 != 0 ? 1 : 4][2], B0[FP8 != 0 ? 1 : 2][2], B1[FP8 != 0 ? 1 : 2][2];
    i32x8 At8[FP8 != 0 ? 4 : 1], B08[FP8 != 0 ? 2 : 1], B18[FP8 != 0 ? 2 : 1];
    (void)At; (void)B0; (void)B1; (void)At8; (void)B08; (void)B18;
    if constexpr (ETAB) { PG8_ETAB_DMA(cur, 0); PG8_WAIT_V(0); PG8_BAR; }
    if constexpr (GATHER != 0) { PG8_GATHER_HALF(0, 0, cur); PG8_GATHER_HALF(1, 0, cur); }
    const char* cA = cur.A; const char* cB = cur.B; const char* cB2 = cur.B2;
    PG8_STAGE(PG8_SB(0, 0), cB, voffB[0], voffB[1]); PG8_STAGE(PG8_SB(0, 1), cB + hstepB, voffB[0], voffB[1]); PG8_STAGE(PG8_SA(0, 0), cA, cvA[0][0], cvA[0][1]); PG8_STAGE(PG8_SA(0, 1), cA, cvA[1][0], cvA[1][1]);
    if (wr == 1) PG8_BAR;
    PG8_WAIT_V(2); PG8_BAR;
    PG8_STAGE(PG8_SB(1, 0), cB + kstep, voffB[0], voffB[1]); PG8_STAGE(PG8_SA(1, 0), cA + kstep, cvA[0][0], cvA[0][1]); PG8_STAGE(PG8_SB(1, 1), cB + hstepB + kstep, voffB[0], voffB[1]);
    PG8_WAIT_V(6); PG8_BAR;
    for (;;) {
        const bool has_next = S.next(ui + 1, nxt);
        const int ebn = (ui + 1) % 3;
        if constexpr (ETAB) { if (has_next) { PG8_ETAB_DMA(nxt, ebn); } }
        const char* nA = has_next ? nxt.A : cA; const char* nB = has_next ? nxt.B : cB;
#define PG8_KTRIP(F8T) { \
            const bool last = (t == nt - 2); \
            const char* a1 = cA + (size_t)(t + 1) * kstep; \
            const char* a2 = last ? nA : cA + (size_t)(t + 2) * kstep; \
            const char* bcur = (SPLITK && (t + 2) >= g.ksplit) ? cB2 : cB; \
            const char* b2 = last ? nB : bcur + (size_t)(t + 2) * kstep; \
            const char* a3 = a2 + kstep; const char* b3 = b2 + kstep; \
            if constexpr (GATHER != 0) { if (last && has_next) { PG8_GATHER_HALF(0, ebn, nxt); } } \
            if constexpr (SSQP) { if (t == 2) { const char* sp_ = g.aux + (size_t)cur.pm * 16384; glds16(sp_, (unsigned)(wid * 2048 + lane * 16), ldsb + (unsigned)ETAB_OFF + (unsigned)wid * 2048u); glds16(sp_, (unsigned)(wid * 2048 + 1024 + lane * 16), ldsb + (unsigned)ETAB_OFF + (unsigned)wid * 2048u + 1024u); } } \
            PG8_LDB(B0, 0, 0); PG8_LDB(B1, 0, 1); PG8_SCHED; PG8_LDA(At, 0, 0); PG8_STAGE(PG8_SA(1, 1), a1, cvA[1][0], cvA[1][1]); \
            if constexpr (GATHER != 0) { if (last && has_next) { PG8_GATHER_HALF(1, ebn, nxt); } } \
            PG8_WAIT_V(8); PG8_WAIT_L(0); PG8_BAR; PG8_MMA(0, 0, At, B0, F8T); PG8_MMA(0, 1, At, B1, F8T); PG8_BAR; PG8_SCHED; \
            PG8_LDA(At, 0, 1); PG8_STAGE(PG8_SB(0, 0), b2, voffB[0], voffB[1]); PG8_STAGE(PG8_SB(0, 1), b2 + hstepB, voffB[0], voffB[1]); PG8_STAGE(PG8_SA(0, 0), a2, cvA[0][0], cvA[0][1]); \
            PG8_WAIT_V(8); PG8_WAIT_L(0); PG8_BAR; PG8_MMA(1, 0, At, B0, F8T); PG8_MMA(1, 1, At, B1, F8T); PG8_BAR; PG8_SCHED; \
            PG8_LDB(B0, 1, 0); PG8_LDB(B1, 1, 1); PG8_SCHED; PG8_LDA(At, 1, 0); PG8_STAGE(PG8_SA(0, 1), a2, cvA[1][0], cvA[1][1]); \
            PG8_WAIT_V(8); PG8_WAIT_L(0); PG8_BAR; PG8_MMA(0, 0, At, B0, F8T); PG8_MMA(0, 1, At, B1, F8T); PG8_BAR; PG8_SCHED; \
            PG8_LDA(At, 1, 1); PG8_STAGE(PG8_SB(1, 0), b3, voffB[0], voffB[1]); PG8_STAGE(PG8_SB(1, 1), b3 + hstepB, voffB[0], voffB[1]); PG8_STAGE(PG8_SA(1, 0), a3, cvA[0][0], cvA[0][1]); \
            PG8_WAIT_V(8); PG8_WAIT_L(0); PG8_BAR; PG8_MMA(1, 0, At, B0, F8T); PG8_MMA(1, 1, At, B1, F8T); PG8_BAR; PG8_SCHED; }
        int t = 0;
        if constexpr (FP8 == 2) {
#pragma nounroll
            for (; t < g.mixk; t += 2) PG8_KTRIP(1)
#pragma nounroll
            for (; t < nt; t += 2) PG8_KTRIP(0)
        } else {
#pragma nounroll
            for (; t < nt; t += 2) PG8_KTRIP(FP8)
        }
#undef PG8_KTRIP
        if (wr == 0) PG8_BAR;
        { const int eoff = opaque_s(SSQP ? ETAB_OFF : ETAB_OFF + (ui % 3) * ETAB_BYTES);
          E(acc, cur, wr, wc, fr, fq, (const LAS u32x4*)(lds + eoff)); }
        if (!has_next) break;
#pragma unroll
        for (int a = 0; a < 2; ++a)
#pragma unroll
            for (int b = 0; b < 2; ++b)
#pragma unroll
                for (int m = 0; m < 4; ++m)
#pragma unroll
                    for (int n = 0; n < 2; ++n) acc[a][b][m][n] = (f32x4){0.f, 0.f, 0.f, 0.f};
        cur = nxt; cA = nA; cB = nB; cB2 = nxt.B2; ++ui;
        if (wr == 1) PG8_BAR;
    }
    PG8_WAIT_V(0);
    PG8_BAR;
#undef PG8_SA
#undef PG8_SB
#undef PG8_STAGE
#undef PG8_LDA
#undef PG8_LDB
#undef PG8_MMA
#undef PG8_LD16
#undef PG8_H0
#undef PG8_H1
#undef PG8_WAIT_V
#undef PG8_WAIT_L
#undef PG8_BAR
#undef PG8_SCHED
#undef PG8_ETAB_DMA
#undef PG8_GATHER_HALF
}

__device__ __forceinline__ u32x4 merge16(u32x2 P, u32x2 Q) {
    const auto r0 = __builtin_amdgcn_permlane16_swap(P.x, Q.x, false, false); const auto r1 = __builtin_amdgcn_permlane16_swap(P.y, Q.y, false, false);
    return (u32x4){r0[0], r1[0], r0[1], r1[1]}; }

struct EpiProj {
    static constexpr bool PERM = true;
    bf16* O; const float* ssq; int coff; float sc_q, sc_o; unsigned char* O8;
    __device__ __forceinline__ void operator()(const f32x4 (&acc)[2][2][4][2], const Unit& u, int wr, int wc, int fr_, int fq_, const LAS u32x4* et) const {
        const int fr = opaque(fr_), fq = opaque(fq_);
        const int row0 = u.pm * BM + wr * 64 + fr, col0 = coff + u.pn * BM + wc * 32 + 8 * fq; const float scx = u.pn < 2 ? sc_q : sc_o;
#pragma unroll
        for (int ai = 0; ai < 2; ++ai)
#pragma unroll
            for (int m = 0; m < 4; ++m) { const int row = row0 + ai * HALF + m * 16;
                const LAS f32x4* sp = (const LAS f32x4*)et + (ai * HALF + wr * 64 + m * 16 + fr) * 4; const f32x4 s0 = sp[0], s1 = sp[1], s2 = sp[2], s3 = sp[3];
                const f32x4 st = (s0 + s1) + (s2 + s3); const float rs = __builtin_amdgcn_rsqf(((st[0] + st[1]) + (st[2] + st[3])) * (1.0f / D) + EPS) * scx;
                bf16* rowp = O + (size_t)row * DIN + col0; unsigned char* rowp8 = O8 + (size_t)row * 1536 + col0 + ((fq & 1) ? HALF - 8 : 0);
                if (O8) { u32x2 w8[2];
#pragma unroll
                    for (int bj = 0; bj < 2; ++bj) { const f32x4 v0 = acc[ai][bj][m][0] * rs, v1 = acc[ai][bj][m][1] * rs; w8[bj].x = pk4_fp8(v0[0], v0[1], v0[2], v0[3]); w8[bj].y = pk4_fp8(v1[0], v1[1], v1[2], v1[3]); }
                    *(u32x4*)rowp8 = merge16(w8[0], w8[1]); }
                else {
#pragma unroll
                    for (int bj = 0; bj < 2; ++bj) { const f32x4 v0 = acc[ai][bj][m][0] * rs, v1 = acc[ai][bj][m][1] * rs;
                        u32x4 w; w.x = cvt_pk_bf16(v0[0], v0[1]); w.y = cvt_pk_bf16(v0[2], v0[3]); w.z = cvt_pk_bf16(v1[0], v1[1]); w.w = cvt_pk_bf16(v1[2], v1[3]);
                        *(u32x4*)(rowp + bj * HALF) = w; } } }
    }
};
struct EpiRes {
    static constexpr bool PERM = true;
    bf16* xb; unsigned char* x8;
    __device__ __forceinline__ void operator()(const f32x4 (&acc)[2][2][4][2], const Unit& u, int wr, int wc, int fr_, int fq_, const LAS u32x4* et) const {
        const int fr = opaque(fr_), fq = opaque(fq_);
        const int row0 = u.pm * BM + wr * 64 + fr, col0 = u.pn * BM + wc * 32 + 8 * fq;
        float DS = 1.0f / (SC_A8 * SC_WGU); asm volatile("" : "+v"(DS));
#pragma unroll
        for (int ai = 0; ai < 2; ++ai) {
            u32x4 xo[4][2];
#pragma unroll
            for (int m = 0; m < 4; ++m)
#pragma unroll
                for (int bj = 0; bj < 2; ++bj) xo[m][bj] = *(const u32x4*)(xb + (size_t)(row0 + ai * HALF + m * 16) * D + col0 + bj * HALF);
            asm volatile("" ::: "memory");
#pragma unroll
            for (int m = 0; m < 4; ++m) { const size_t ro = (size_t)(row0 + ai * HALF + m * 16) * D + col0; u32x2 q8[2];
#pragma unroll
                for (int bj = 0; bj < 2; ++bj) { const u32x4 w0 = xo[m][bj]; const f32x4 a0 = acc[ai][bj][m][0], a1 = acc[ai][bj][m][1]; u32x4 w;
                    const float v0 = __builtin_fmaf(a0[0], DS, bf_lo(w0.x)), v1 = __builtin_fmaf(a0[1], DS, bf_hi(w0.x)), v2 = __builtin_fmaf(a0[2], DS, bf_lo(w0.y)), v3 = __builtin_fmaf(a0[3], DS, bf_hi(w0.y)), v4 = __builtin_fmaf(a1[0], DS, bf_lo(w0.z)), v5 = __builtin_fmaf(a1[1], DS, bf_hi(w0.z)), v6 = __builtin_fmaf(a1[2], DS, bf_lo(w0.w)), v7 = __builtin_fmaf(a1[3], DS, bf_hi(w0.w));
                    w.x = cvt_pk_bf16(v0, v1); w.y = cvt_pk_bf16(v2, v3); w.z = cvt_pk_bf16(v4, v5); w.w = cvt_pk_bf16(v6, v7);
                    *(u32x4*)(xb + ro + bj * HALF) = w;
                    q8[bj].x = pk4_fp8(v0 * SC_X8, v1 * SC_X8, v2 * SC_X8, v3 * SC_X8); q8[bj].y = pk4_fp8(v4 * SC_X8, v5 * SC_X8, v6 * SC_X8, v7 * SC_X8); }
                *(u32x4*)(x8 + ro + ((fq & 1) ? HALF - 8 : 0)) = merge16(q8[0], q8[1]); }
            asm volatile("" ::: "memory"); }
    }
};
struct EpiSwiglu {
    static constexpr bool PERM = true;
    unsigned char* H;
    __device__ __forceinline__ void operator()(const f32x4 (&acc)[2][2][4][2], const Unit& u, int wr, int wc, int fr_, int fq_, const LAS u32x4* et) const {
        const int fr = opaque(fr_), fq = opaque(fq_);
        const int ehalf = u.sub >> 2, jblk = u.sub & 3;
        const int col0 = ehalf * DE + jblk * HALF + wc * 32 + 8 * fq;
#pragma unroll
        for (int ai = 0; ai < 2; ++ai)
#pragma unroll
            for (int mp = 0; mp < 2; ++mp) { u32x2 o[2];
#pragma unroll
                for (int mm = 0; mm < 2; ++mm) { const int m = 2 * mp + mm; const int lr = ai * HALF + wr * 64 + m * 16 + fr;
                    const u32x4 e = et[lr]; const unsigned ey = e.y, ew = ehalf ? e.w : e.z;
                    const float rs = __uint_as_float(ey), w = __uint_as_float(ew);
                    float hv[8];
#pragma unroll
                    for (int n = 0; n < 2; ++n)
#pragma unroll
                        for (int k = 0; k < 4; ++k) { const float gt = acc[ai][0][m][n][k] * rs, up = acc[ai][1][m][n][k] * rs;
                            const float sg = gt * fast_rcp(1.0f + fast_exp2(-LOG2E * gt)); hv[n * 4 + k] = sg * up * w; }
                    o[mm].x = pk4_fp8(hv[0], hv[1], hv[2], hv[3]); o[mm].y = pk4_fp8(hv[4], hv[5], hv[6], hv[7]); }
                const int lrs = ai * HALF + wr * 64 + (2 * mp + (fq & 1)) * 16 + fr;
                *(u32x4*)(H + (size_t)(u.tile * BM + lrs) * D + col0 - ((fq & 1) ? 8 : 0)) = merge16(o[0], o[1]); }
    }
};
struct EpiScatter {
    static constexpr bool PERM = true;
    bf16* xb; float* ssq; unsigned char* x8;
    __device__ __forceinline__ void operator()(const f32x4 (&acc)[2][2][4][2], const Unit& u, int wr, int wc, int fr_, int fq_, const LAS u32x4* et) const {
        const int fr = opaque(fr_), fq = opaque(fq_);
        const int col0 = u.pn * BM + wc * 32 + 8 * fq;
        float DS = 1.0f / (SC_H8 * SC_WD); asm volatile("" : "+v"(DS));
#pragma unroll
        for (int ai = 0; ai < 2; ++ai) {
            unsigned tok[4]; u32x4 xo[4][2];
#pragma unroll
            for (int m = 0; m < 4; ++m) tok[m] = et[ai * HALF + wr * 64 + m * 16 + fr].x;
#pragma unroll
            for (int m = 0; m < 4; ++m)
#pragma unroll
                for (int bj = 0; bj < 2; ++bj) xo[m][bj] = *(const u32x4*)(xb + (size_t)tok[m] * D + col0 + bj * HALF);
            asm volatile("" ::: "memory");
            float ssm[4];
#pragma unroll
            for (int m = 0; m < 4; ++m) { const int lr = ai * HALF + wr * 64 + m * 16 + fr; const bool valid = lr < u.nvalid; const size_t ro = (size_t)tok[m] * D + col0; float ss = 0.f; u32x2 q8[2];
#pragma unroll
                for (int bj = 0; bj < 2; ++bj) { const u32x4 w0 = xo[m][bj]; const f32x4 a0 = acc[ai][bj][m][0], a1 = acc[ai][bj][m][1]; u32x4 w;
                    w.x = cvt_pk_bf16(__builtin_fmaf(a0[0], DS, bf_lo(w0.x)), __builtin_fmaf(a0[1], DS, bf_hi(w0.x))); w.y = cvt_pk_bf16(__builtin_fmaf(a0[2], DS, bf_lo(w0.y)), __builtin_fmaf(a0[3], DS, bf_hi(w0.y)));
                    w.z = cvt_pk_bf16(__builtin_fmaf(a1[0], DS, bf_lo(w0.z)), __builtin_fmaf(a1[1], DS, bf_hi(w0.z))); w.w = cvt_pk_bf16(__builtin_fmaf(a1[2], DS, bf_lo(w0.w)), __builtin_fmaf(a1[3], DS, bf_hi(w0.w)));
                    const float r0 = bf_lo(w.x), r1 = bf_hi(w.x), r2 = bf_lo(w.y), r3 = bf_hi(w.y), r4 = bf_lo(w.z), r5 = bf_hi(w.z), r6 = bf_lo(w.w), r7 = bf_hi(w.w);
                    ss += ((r0 * r0 + r1 * r1) + (r2 * r2 + r3 * r3)) + ((r4 * r4 + r5 * r5) + (r6 * r6 + r7 * r7));
                    q8[bj].x = pk4_fp8(r0 * SC_X8, r1 * SC_X8, r2 * SC_X8, r3 * SC_X8); q8[bj].y = pk4_fp8(r4 * SC_X8, r5 * SC_X8, r6 * SC_X8, r7 * SC_X8);
                    if (valid) *(u32x4*)(xb + ro + bj * HALF) = w; }
                { const u32x4 q16 = merge16(q8[0], q8[1]);
                  if (valid) *(u32x4*)(x8 + ro + ((fq & 1) ? HALF - 8 : 0)) = q16; }
                ss += __shfl_xor(ss, 16); ss += __shfl_xor(ss, 32); ssm[m] = ss; }
            { const float sst = fq == 0 ? ssm[0] : fq == 1 ? ssm[1] : fq == 2 ? ssm[2] : ssm[3]; const unsigned tokt = fq == 0 ? tok[0] : fq == 1 ? tok[1] : fq == 2 ? tok[2] : tok[3];
              if (ai * HALF + wr * 64 + fq * 16 + fr < u.nvalid) ssq[(size_t)tokt * 16 + u.pn * 4 + wc] = sst; }
            asm volatile("" ::: "memory"); }
    }
};
}

template <int SUB> struct MoeOrder {
    const volatile LAS int* tb;
    const volatile LAS int* cnt;
    int nunits, G, c;
    const char* A; const char* W; const u32x4* list;
    __device__ __forceinline__ bool next(int i, pg8::Unit& u) const {
        const int L = i * G + c; if (L >= nunits) return false;
        const int tile = L / SUB, sub = L % SUB;
        int k = 0; while (tb[k + 1] <= tile) ++k;
        const int tin = tile - tb[k]; const int rem = cnt[k] - tin * 256;
        u.nvalid = rem < 256 ? rem : 256; u.rows = list + (size_t)k * T + (size_t)tin * 256; u.tile = tile; u.sub = sub; u.pm = tile;
        const int gi = k / 6, p = k % 6; const int a = p < 3 ? 0 : (p < 5 ? 1 : 2); const int b = p < 3 ? p + 1 : (p < 5 ? p - 1 : 3);
        const int ea = gi * 4 + a, eb = gi * 4 + b;
        if (SUB == 8) {
            const int ehalf = sub >> 2, jblk = sub & 3; u.pn = sub; u.A = A;
            u.B = W + ((size_t)(ehalf ? eb : ea) * 1024 + (size_t)jblk * 128) * (size_t)D; u.B2 = u.B;
        } else {
            u.pn = sub; u.A = A;
            u.B = W + ((size_t)ea * 1024 + (size_t)sub * 256) * (size_t)DE;
            u.B2 = W + ((size_t)eb * 1024 + (size_t)sub * 256) * (size_t)DE - (size_t)4 * 128;
        }
        return true;
    }
};

__device__ __forceinline__ float wave_sum(float v) {
#pragma unroll
    for (int o = 1; o < 64; o <<= 1) v += __shfl_xor(v, o);
    return v;
}
__device__ __forceinline__ void weff_task(const float* pw, const float* ps, const float* wo, unsigned char* WT, int g, int kb8, int n0, int lane) {
    const float* wog = wo + (size_t)(512 + g * 128) * D + n0 + lane; const float* psg = ps + g * 128; const float* pr = pw + ((size_t)g * 128 + kb8 * 8) * 128;
    float a[8];
#pragma unroll
    for (int q = 0; q < 8; ++q) a[q] = 0.f;
    for (int j0 = 0; j0 < 128; j0 += 32) { float wv[32];
#pragma unroll
        for (int jj = 0; jj < 32; ++jj) wv[jj] = wog[(size_t)(j0 + jj) * D];
#pragma unroll
        for (int jj = 0; jj < 32; ++jj) { const float sw = wv[jj] * psg[j0 + jj];
#pragma unroll
            for (int q = 0; q < 8; ++q) a[q] += pr[q * 128 + j0 + jj] * sw; } }
    constexpr float WS_ = SC_A8 * SC_WGU;
    u32x4 o; o.x = pk2(a[0] * WS_, a[1] * WS_); o.y = pk2(a[2] * WS_, a[3] * WS_); o.z = pk2(a[4] * WS_, a[5] * WS_); o.w = pk2(a[6] * WS_, a[7] * WS_);
    *(u32x4*)(WT + (size_t)(n0 + lane) * MIXP + 512 + (size_t)(g * 128 + kb8 * 8) * 2) = o;
}

#define CONVERT_WEIGHTS(L0_, L1_, GW_, NGW_) { \
        constexpr int I_IN = 16 * 64, I_OT = 8 * 32, I_G = 16 * 16, I_D = 8 * 32; \
        constexpr int PER_LAYER = I_IN + I_OT + NE * (2 * I_G + I_D); const int cfirst_ = (L0_) * PER_LAYER + (GW_), NCONV = (L1_) * PER_LAYER; \
        struct Item { const float* W; const float* ks; unsigned char* dst; int ldw, k0, n0, pitch, f8; float ns; }; \
        auto decode = [&](int it) -> Item { Item I; const int l = it / PER_LAYER; int r = it % PER_LAYER; \
            if (r < I_IN) { const int kb = r / 64, nb = r % 64; I.W = w_in + (size_t)l * D * DIN; I.ldw = DIN; I.ks = norm_mix_g + l * D; I.k0 = 64 * kb; I.n0 = 32 * nb; \
                if (nb < 48) { I.dst = Win8 + (size_t)l * 1536 * D; I.pitch = D; I.f8 = 1; I.ns = SC_WGU; } \
                else { I.dst = (unsigned char*)(Win_t + (size_t)l * DIN * D); I.pitch = D * 2; I.f8 = 0; I.ns = 1.0f; } \
                return I; } r -= I_IN; \
            if (r < I_OT) { const int kb = r / 32, nb = r % 32; I.W = w_out + (size_t)l * D * D; I.ldw = D; I.ks = nullptr; I.k0 = 64 * kb; I.n0 = 32 * nb; I.dst = Wout8 + (size_t)l * D * MIXP; I.pitch = MIXP; I.f8 = 1; I.ns = SC_WGU; return I; } r -= I_OT; \
            const int e = r / (2 * I_G + I_D); r %= (2 * I_G + I_D); const size_t le = (size_t)l * NE + e; \
            if (r < 2 * I_G) { const int up = r >= I_G; r -= up * I_G; const int kb = r / 16, nb = r % 16; I.W = (up ? w_up : w_gate) + le * D * DE; I.ldw = DE; I.ks = norm_ffn_g + l * D; I.k0 = 64 * kb; I.n0 = 32 * nb; \
                I.dst = Wgu8 + le * 1024 * D + (size_t)(up ? 512 : 0) * D; I.pitch = D; I.f8 = 1; I.ns = SC_WGU; return I; } r -= 2 * I_G; \
            { const int kb = r / 32, nb = r % 32; I.W = w_down + le * DE * D; I.ldw = D; I.ks = nullptr; I.k0 = 64 * kb; I.n0 = 32 * nb; I.dst = Wd8 + le * 1024 * DE; I.pitch = DE; I.f8 = 1; I.ns = SC_WD; return I; } }; \
        f32x4 cur[8], nxt[8], nx2[8];     \
_Pragma("unroll") \
        for (int i = 0; i < 8; ++i) { cur[i] = (f32x4){0.f, 0.f, 0.f, 0.f}; nxt[i] = cur[i]; nx2[i] = cur[i]; } \
        if (cfirst_ < NCONV) { const Item I = decode(cfirst_); \
_Pragma("unroll") \
            for (int i = 0; i < 8; ++i) cur[i] = *(const f32x4*)(I.W + (size_t)(I.k0 + 8 * i + (lane >> 3)) * I.ldw + I.n0 + (lane & 7) * 4); } \
        if (cfirst_ + (NGW_) < NCONV) { const Item I = decode(cfirst_ + (NGW_)); \
_Pragma("unroll") \
            for (int i = 0; i < 8; ++i) nxt[i] = *(const f32x4*)(I.W + (size_t)(I.k0 + 8 * i + (lane >> 3)) * I.ldw + I.n0 + (lane & 7) * 4); } \
        for (int it = cfirst_; it < NCONV; it += (NGW_)) { \
            const Item I = decode(it); \
            if (it + 2 * (NGW_) < NCONV) { const Item J = decode(it + 2 * (NGW_)); \
_Pragma("unroll") \
                for (int i = 0; i < 8; ++i) nx2[i] = *(const f32x4*)(J.W + (size_t)(J.k0 + 8 * i + (lane >> 3)) * J.ldw + J.n0 + (lane & 7) * 4); } \
_Pragma("unroll") \
            for (int i = 0; i < 8; ++i) { const int kk = 8 * i + (lane >> 3); f32x4 v = cur[i]; float sc_ = I.ns; if (I.ks) sc_ *= I.ks[I.k0 + kk]; v *= sc_; \
                LAS float* d_ = scr + kk * 33 + (lane & 7) * 4; d_[0] = v[0]; d_[1] = v[1]; d_[2] = v[2]; d_[3] = v[3]; } \
            LDS_WAIT(); asm volatile("" ::: "memory"); \
            const int c = lane & 7; \
_Pragma("unroll") \
            for (int j = 0; j < 4; ++j) { const int n = (lane >> 3) + 8 * j; const LAS float* s = scr + (8 * c) * 33 + n; \
                if (I.f8) { u32x2 o; o.x = pk4_fp8(s[0 * 33], s[1 * 33], s[2 * 33], s[3 * 33]); o.y = pk4_fp8(s[4 * 33], s[5 * 33], s[6 * 33], s[7 * 33]); \
                    *(u32x2*)(I.dst + (size_t)(I.n0 + n) * I.pitch + I.k0 + 8 * c) = o; } \
                else { u32x4 o; o.x = pk2(s[0 * 33], s[1 * 33]); o.y = pk2(s[2 * 33], s[3 * 33]); o.z = pk2(s[4 * 33], s[5 * 33]); o.w = pk2(s[6 * 33], s[7 * 33]); \
                    *(u32x4*)(I.dst + (size_t)(I.n0 + n) * I.pitch + (size_t)(I.k0 + 8 * c) * 2) = o; } } \
            LDS_WAIT(); asm volatile("" ::: "memory"); \
_Pragma("unroll") \
            for (int i = 0; i < 8; ++i) { cur[i] = nxt[i]; nxt[i] = nx2[i]; } \
        } \
        for (int it = (L0_) * 1024 + (GW_); it < (L1_) * 1024; it += (NGW_)) { const int l = it >> 10, r = it & 1023, g = r >> 8, kb8 = (r >> 4) & 15, nc = r & 15; \
            weff_task(pool_w + (size_t)l * 4 * 128 * 128, pool_scale + l * 512, w_out + (size_t)l * D * D, Wout8 + (size_t)l * D * MIXP, g, kb8, 64 * nc, lane); } \
        for (int it = (L0_) * 4096 + (GW_) * 64 + lane; it < (L1_) * 4096; it += (NGW_) * 64) { \
            const int l = it >> 12, step = (it >> 6) & 63, ln = it & 63, m = ln & 31, kg = ln >> 5, kb = (step >> 2) * 64 + kg * 32 + (step & 3) * 8; \
            unsigned hw[4], lw[4]; \
_Pragma("unroll") \
            for (int jj = 0; jj < 4; ++jj) { float v[2]; \
_Pragma("unroll") \
                for (int q = 0; q < 2; ++q) { const int k = kb + 2 * jj + q; float w = 0.f; \
                    if (m < 8) w = w_rg[((size_t)l * D + k) * 4 + (m & 3)]; else if (m < 24) w = w_re[((size_t)l * D + k) * 16 + (m - 8)]; \
                    v[q] = w * norm_ffn_g[l * D + k]; } \
                const unsigned h = pk2(v[0], v[1]); hw[jj] = h; lw[jj] = pk2(v[0] - bf_lo(h), v[1] - bf_hi(h)); } \
            rfrag[(size_t)l * 8192 + (size_t)(0 * 64 + step) * 64 + ln] = (u32x4){hw[0], hw[1], hw[2], hw[3]}; \
            rfrag[(size_t)l * 8192 + (size_t)(1 * 64 + step) * 64 + ln] = (u32x4){lw[0], lw[1], lw[2], lw[3]}; \
        } }

struct Args { const float* in[14]; float* out; unsigned char* ws; int ph_lo, ph_hi, li, pad; };
constexpr int N_PHASES = 2 + 6 * DEPTH;

__global__ void __launch_bounds__(NTHREADS, 2) enc_fwd(Args args) {
    extern __shared__ __attribute__((aligned(16))) unsigned char lds_raw[];
    LAS unsigned char* lds = (LAS unsigned char*)lds_raw;
    volatile LAS unsigned* MISC = (volatile LAS unsigned*)(lds + MISC_OFF);
    const int wave_s = __builtin_amdgcn_readfirstlane((int)threadIdx.x >> 6);
    const int G = gridDim.x; const int bx = blockIdx.x; const int vcu = (G % 8 == 0) ? (bx % 8) * (G / 8) + bx / 8 : bx;
    unsigned char* ws = args.ws;
    gu32* ctl = (gu32*)(ws + WS_CTL);
    const float* x_in = args.in[0]; const float* norm_mix_g = args.in[1]; const float* w_in = args.in[2]; const float* rpb = args.in[3];
    const float* pool_w = args.in[4]; const float* pool_scale = args.in[5]; const float* w_out = args.in[6]; const float* norm_ffn_g = args.in[7];
    const float* w_rg = args.in[8]; const float* w_re = args.in[9]; const float* w_gate = args.in[10]; const float* w_up = args.in[11]; const float* w_down = args.in[12];
    const float* final_g = args.in[13];
#define WS_PTRS() GAS unsigned char* wsg_ = (GAS unsigned char*)ws; asm volatile("" : "+s"(wsg_)); unsigned char* wsp = (unsigned char*)wsg_;     \
    bf16* Win_t = (bf16*)(wsp + WS_WIN); bf16* Wout_t = (bf16*)(wsp + WS_WOUT); unsigned char* Wgu8 = wsp + WS_WGU; unsigned char* Wd8 = wsp + WS_WD; unsigned char* x8 = wsp + WS_X8; unsigned char* H8 = wsp + WS_H; unsigned char* Win8 = wsp + WS_WIN8; unsigned char* qkv8 = wsp + WS_QKV8; \
    u32x4* rfrag = (u32x4*)(wsp + WS_RFRAG); float* ssq = (float*)(wsp + WS_SSQ); u32x4* list = (u32x4*)(wsp + WS_LIST); \
    bf16* xb = (bf16*)(wsp + WS_XB); bf16* proj = (bf16*)(wsp + WS_PROJ); unsigned char* mix8 = wsp + WS_MIX; unsigned char* Wout8 = wsp + WS_WOUT; \
    (void)Win_t; (void)Win8; (void)qkv8; (void)Wout_t; (void)Wgu8; (void)Wd8; (void)x8; (void)H8; (void)rfrag; (void)ssq; (void)list; (void)xb; (void)proj; (void)mix8; (void)Wout8

    for (int u = threadIdx.x; u < 128; u += NTHREADS) MISC[u] = 0u;
    __syncthreads();
    XcdBarrier bar; bar.bar = (unsigned*)(ctl + CW_BAR); bar.x = 0; bar.st = nullptr;
    if (MK_N_LAUNCHES == 1) bar = xcd_barrier_post((unsigned*)(ctl + CW_BAR), MISC + MW_BAR);
    const int lo = args.ph_lo, hi = args.ph_hi;
#define IN(k) (lo <= (k) && (k) < hi)
#define SEAM(k) do { if (IN(k) && IN((k) + 1)) xcd_barrier(bar, wave_s == 0 && lane_id() == 0); } while (0)
    const int NGW = G * NWAVES;
#define PHASE_IDS() const int wave = opaque_s(wave_s), lane = lane_id(), tid = wave * 64 + lane, gw = opaque_s(vcu) * NWAVES + wave; (void)gw; (void)tid

    if (IN(0)) for (int rep_ = 0; rep_ < REP_P0; ++rep_) {
        WS_PTRS();
        PHASE_IDS();
        __syncthreads();
        LAS float* scr = (LAS float*)(lds + wave * 16384);
        CONVERT_WEIGHTS(0, 1, gw, NGW)
        for (int m0 = gw * 4; m0 < T; m0 += NGW * 4) {
            f32x4 v[4][4];
#pragma unroll
            for (int rr = 0; rr < 4; ++rr) { const f32x4* xr = (const f32x4*)(x_in + (size_t)(m0 + rr) * D) + lane;
#pragma unroll
                for (int j = 0; j < 4; ++j) v[rr][j] = xr[64 * j]; }
#pragma unroll
            for (int rr = 0; rr < 4; ++rr) { float s = 0.f;
#pragma unroll
                for (int j = 0; j < 4; ++j) s += (v[rr][j][0] * v[rr][j][0] + v[rr][j][1] * v[rr][j][1]) + (v[rr][j][2] * v[rr][j][2] + v[rr][j][3] * v[rr][j][3]);
                s = wave_sum(s);
                u32x2* o8 = (u32x2*)(xb + (size_t)(m0 + rr) * D) + lane;
#pragma unroll
                for (int j = 0; j < 4; ++j) { u32x2 w; w.x = cvt_pk_bf16(v[rr][j][0], v[rr][j][1]); w.y = cvt_pk_bf16(v[rr][j][2], v[rr][j][3]); o8[64 * j] = w;
                    ((unsigned*)(x8 + (size_t)(m0 + rr) * D))[lane + 64 * j] = pk4_fp8(v[rr][j][0] * SC_X8, v[rr][j][1] * SC_X8, v[rr][j][2] * SC_X8, v[rr][j][3] * SC_X8); }
                if (lane < 16) ssq[(size_t)(m0 + rr) * 16 + lane] = lane == 0 ? s : 0.f; }
        }
        LDS_WAIT();
    }
    SEAM(0);

    for (int l = 0; l < DEPTH; ++l) {
        const int pb = 1 + 6 * l;
        if (IN(pb)) for (int rep_ = 0; rep_ < REP_P1; ++rep_) {
        WS_PTRS();
            {
                pg8::Gemm g{D / 2, D / 2, D / 2, 1 << 20, (unsigned)(128 * D), (const char*)ssq};
                pg8::StaticOrder S; S.init(x8, Win8 + (size_t)l * 1536 * D, D / 2, D / 2, T, 1536, G, opaque_s(bx), 1);
                pg8::EpiProj E{proj, ssq, 0, SC_Q8 * 0.125f * LOG2E / (SC_X8 * SC_WGU), SC_KV8 / (SC_X8 * SC_WGU), qkv8};
                pg8::gemm_phase<pg8::EpiProj, pg8::StaticOrder, false, 2, false, true, true>(lds, wave_s, g, S, E); }
            {
                pg8::Gemm g{D, D, D, 1 << 20, (unsigned)(128 * D * 2), (const char*)ssq};
                pg8::StaticOrder S; S.init(xb, Win_t + ((size_t)l * DIN + 1536) * D, D, D, T, 512, G, opaque_s(bx), 0);
                pg8::EpiProj E{proj, ssq, 1536, 1.0f, 1.0f, nullptr};
                pg8::gemm_phase<pg8::EpiProj, pg8::StaticOrder, false, 0, false, false, true>(lds, wave_s, g, S, E); }
        }
        SEAM(pb);
        if (IN(pb + 1)) for (int rep_ = 0; rep_ < REP_P2; ++rep_) {
        WS_PTRS();
        PHASE_IDS();
            LAS float* rpbs = (LAS float*)(lds + BIAS_OFF);
            const int g4 = lane >> 4, q = lane & 15, n = wave & 3, rpar = wave >> 2;
            const int kcs = (n == 0) ? 0 : (n == 1) ? 8 : (n == 2) ? 24 : 32;
            const int qc = 16 * n + q, qs = (qc - 8) < 0 ? 0 : ((qc - 8) > 48 ? 48 : (qc - 8));
            bool pooled_inline = false;
            for (int bh = bx; bh < BATCH * NH; bh += G) {
                const int b = bh >> 3, h = bh & 7;
                __syncthreads();
                for (int i = tid; i < 465; i += NTHREADS) rpbs[i] = rpb[((size_t)l * NH + h) * 465 + i] * LOG2E;
                const int kvh = tid >> 8, ctok = (tid & 255) >> 2, c4 = tid & 3, csw = kvh ? (((ctok >> 1) & 3) << 1) : ((ctok >> 1) & 7);
                const unsigned wofs0 = (unsigned)((kvh ? VRING_OFF : KRING_OFF) + ctok * 128 + (((2 * c4) ^ csw) * 16)), wofs1 = (unsigned)((kvh ? VRING_OFF : KRING_OFF) + ctok * 128 + (((2 * c4 + 1) ^ csw) * 16));
                const unsigned char* kvsrc = qkv8 + (size_t)(b * SEQ + ctok) * 1536 + 512 + kvh * 512 + h * 64 + c4 * 16;
#define RING_PUT(SLOT_, W_) do { const u32x4 w__ = (W_); const u32x2 a_ = fp8x4_to_bf16x4(w__[0], 1.0f), b_ = fp8x4_to_bf16x4(w__[1], 1.0f), c_ = fp8x4_to_bf16x4(w__[2], 1.0f), d_ = fp8x4_to_bf16x4(w__[3], 1.0f); \
                    *(LAS u32x4*)(lds + (SLOT_) * 8192 + wofs0) = (u32x4){a_[0], a_[1], b_[0], b_[1]}; *(LAS u32x4*)(lds + (SLOT_) * 8192 + wofs1) = (u32x4){c_[0], c_[1], d_[0], d_[1]}; } while (0)
#pragma unroll
                for (int half = 0; half < 2; ++half) { u32x4 kv[4];
#pragma unroll
                    for (int j = 0; j < 4; ++j) { const int kr = half * 4 + j; kv[j] = __builtin_nontemporal_load((const u32x4*)(kvsrc + (size_t)kr * 64 * 1536)); }
#pragma unroll
                    for (int j = 0; j < 4; ++j) { const int kr = half * 4 + j; RING_PUT(kr, kv[j]); } }
                int hi_loaded = 7, cur_shift = 1000;
                const unsigned char* qbase = qkv8 + (size_t)(b * SEQ + 16 * n + q) * 1536 + h * 64 + 8 * g4;
                u32x2 qn0 = *(const u32x2*)(qbase + (size_t)rpar * 64 * 1536), qn1 = *(const u32x2*)(qbase + (size_t)rpar * 64 * 1536 + 32);
                const int w0 = qs - kcs;
                const bool sel0_0 = (4 * g4 + 0) >= w0, sel0_1 = (4 * g4 + 1) >= w0, sel0_2 = (4 * g4 + 2) >= w0, sel0_3 = (4 * g4 + 3) >= w0;
                const unsigned m01 = (sel0_0 ? 0x0000ffffu : 0u) | (sel0_1 ? 0xffff0000u : 0u), m23 = (sel0_2 ? 0x0000ffffu : 0u) | (sel0_3 ? 0xffff0000u : 0u);
                unsigned bmp[8][2];
#pragma unroll
                for (int i = 0; i < 8; ++i) { bmp[i][0] = 0u; bmp[i][1] = 0u; }
                const int prg = bx * NWAVES + wave; const bool do_pool = (bh == bx) && (prg < T / 32);
                const int phalf = 1 << (lane >> 4), ptb0 = (prg * 32) % SEQ;
                const bf16* pub = proj + (size_t)((prg * 32) / SEQ) * SEQ * DIN + 1536 + lane * 8; unsigned char* pob = mix8 + (size_t)((prg * 32) / SEQ) * SEQ * MIXP + 512 + lane * 16;
                float psum[8];
#pragma unroll
                for (int c = 0; c < 8; ++c) psum[c] = 0.f;
                if (do_pool) { for (int d = -8; d < 8; ++d) { const int j = ptb0 + d; if (d >= -phalf && d < phalf && j >= 0 && j < SEQ) { const u32x4 w = *(const u32x4*)(pub + (size_t)j * DIN);
                        psum[0] += bf_lo(w.x); psum[1] += bf_hi(w.x); psum[2] += bf_lo(w.y); psum[3] += bf_hi(w.y); psum[4] += bf_lo(w.z); psum[5] += bf_hi(w.z); psum[6] += bf_lo(w.w); psum[7] += bf_hi(w.w); } } }
                pooled_inline = pooled_inline || do_pool;
                __syncthreads();
                for (int s = 0; s < 16; ++s) {
                    const int r = 2 * s + rpar;
                    u32x4 pl_[2][3];
#pragma unroll
                    for (int tt = 0; tt < 2; ++tt) { const int t = ptb0 + 2 * s + tt; const int ta = (t + phalf) > SEQ - 1 ? SEQ - 1 : (t + phalf), ts = (t - phalf) < 0 ? 0 : (t - phalf);
                        pl_[tt][0] = *(const u32x4*)(pub + (size_t)t * DIN); pl_[tt][1] = *(const u32x4*)(pub + (size_t)ta * DIN); pl_[tt][2] = *(const u32x4*)(pub + (size_t)ts * DIN); }
                    int next_hi = hi_loaded;
                    if (s < 15) { int rs1 = 2 * s + 3 - 4; rs1 = rs1 < 0 ? 0 : (rs1 > 24 ? 24 : rs1); next_hi = rs1 + 7; }
                    const int nnew = next_hi - hi_loaded;
                    u32x4 pk_[2];
#pragma unroll
                    for (int j = 0; j < 2; ++j) { int kr = hi_loaded + 1 + j; kr = kr > ROWS - 1 ? ROWS - 1 : kr;
                        pk_[j] = __builtin_nontemporal_load((const u32x4*)(kvsrc + (size_t)kr * 64 * 1536)); }
                    int rst = r - 4; rst = rst < 0 ? 0 : (rst > 24 ? 24 : rst);
                    const int shift = rst - r;
                    if (shift != cur_shift) { cur_shift = shift;
#pragma unroll
                        for (int i = 0; i < 8; ++i) { float bv[4];
#pragma unroll
                            for (int e = 0; e < 4; ++e) { const int c = 4 * g4 + e; const int kc = kcs + (c >= w0 ? c : 16 + c);
                                int dc = kc - qc + 15; dc = dc < 0 ? 0 : (dc > 30 ? 30 : dc); const int dr = shift + i + 7;
                                bv[e] = rpbs[dr * 31 + dc]; }
                            bmp[i][0] = cvt_pk_bf16(bv[0], bv[1]); bmp[i][1] = cvt_pk_bf16(bv[2], bv[3]); } }
                    const size_t tq = (size_t)(b * SEQ + r * 64 + 16 * n + q);
                    bf16x8 qf0, qf1;
                    { constexpr float QS = 1.0f / (SC_Q8 * SC_KV8); const u32x2 a0 = fp8x4_to_bf16x4(qn0.x, QS), a1 = fp8x4_to_bf16x4(qn0.y, QS), b0 = fp8x4_to_bf16x4(qn1.x, QS), b1 = fp8x4_to_bf16x4(qn1.y, QS);
                      qf0 = __builtin_bit_cast(bf16x8, (u32x4){a0.x, a0.y, a1.x, a1.y}); qf1 = __builtin_bit_cast(bf16x8, (u32x4){b0.x, b0.y, b1.x, b1.y}); }
                    { const int rn = (r + 2) > ROWS - 1 ? ROWS - 1 : (r + 2); qn0 = *(const u32x2*)(qbase + (size_t)rn * 64 * 1536); qn1 = *(const u32x2*)(qbase + (size_t)rn * 64 * 1536 + 32); }
                    f32x4 sc[8][2];
                    const int slot0 = rst % 9;
#pragma unroll
                    for (int i = 0; i < 8; ++i) { int slot = slot0 + i; slot = slot >= 9 ? slot - 9 : slot;
                        const f32x4 binit = (f32x4){bf_lo(bmp[i][0]), bf_hi(bmp[i][0]), bf_lo(bmp[i][1]), bf_hi(bmp[i][1])};
#pragma unroll
                        for (int jb = 0; jb < 2; ++jb) { const int tok = kcs + 16 * jb + q; const int sw = (tok >> 1) & 7;
                            const LAS unsigned char* kp = lds + KRING_OFF + slot * 8192 + tok * 128;
                            const bf16x8 k0 = *(const LAS bf16x8*)(kp + ((g4 ^ sw) * 16)), k1 = *(const LAS bf16x8*)(kp + (((4 + g4) ^ sw) * 16));
                            f32x4 a = __builtin_amdgcn_mfma_f32_16x16x32_bf16(k0, qf0, binit, 0, 0, 0);
                            sc[i][jb] = __builtin_amdgcn_mfma_f32_16x16x32_bf16(k1, qf1, a, 0, 0, 0); } }
                    float sv[8][4];
#pragma unroll
                    for (int i = 0; i < 8; ++i) { sv[i][0] = sel0_0 ? sc[i][0][0] : sc[i][1][0]; sv[i][1] = sel0_1 ? sc[i][0][1] : sc[i][1][1]; sv[i][2] = sel0_2 ? sc[i][0][2] : sc[i][1][2]; sv[i][3] = sel0_3 ? sc[i][0][3] : sc[i][1][3]; }
                    float mxa = max3f(sv[0][0], sv[0][1], sv[0][2]), mxb = max3f(sv[0][3], sv[1][0], sv[1][1]);
                    mxa = max3f(mxa, sv[1][2], sv[1][3]);
#pragma unroll
                    for (int i = 2; i < 8; ++i) { mxa = max3f(mxa, sv[i][0], sv[i][1]); mxb = max3f(mxb, sv[i][2], sv[i][3]); }
                    float mx = fmaxf(mxa, mxb);
                    mx = fmaxf(mx, __shfl_xor(mx, 16)); mx = fmaxf(mx, __shfl_xor(mx, 32));
                    f32x2 lsum2 = (f32x2){0.f, 0.f}; const f32x2 mx2 = (f32x2){mx, mx}; bf16x8 pf[8];
#pragma unroll
                    for (int i = 0; i < 8; ++i) { const f32x2 d01 = (f32x2){sv[i][0], sv[i][1]} - mx2, d23 = (f32x2){sv[i][2], sv[i][3]} - mx2;
                        f32x2 p01, p23; p01.x = fast_exp2(d01.x); p01.y = fast_exp2(d01.y); p23.x = fast_exp2(d23.x); p23.y = fast_exp2(d23.y);
                        lsum2 += p01 + p23;
                        const unsigned pk01 = cvt_pk_bf16(p01.x, p01.y), pk23 = cvt_pk_bf16(p23.x, p23.y);
                        u32x4 w; w.x = pk01 & m01; w.y = pk23 & m23; w.z = pk01 ^ w.x; w.w = pk23 ^ w.y;
                        pf[i] = __builtin_bit_cast(bf16x8, w); }
                    float lsum = lsum2.x + lsum2.y;
                    lsum += __shfl_xor(lsum, 16); lsum += __shfl_xor(lsum, 32);
                    f32x4 o[4];
#pragma unroll
                    for (int hb = 0; hb < 4; ++hb) o[hb] = (f32x4){0.f, 0.f, 0.f, 0.f};
                    const int qq = q >> 2, pp = lane & 3;
                    const int tokx = kcs + 4 * g4 + qq, toky = tokx + 16;
                    const int swx = ((tokx >> 1) & 3) << 1, swy = ((toky >> 1) & 3) << 1;
#pragma unroll
                    for (int i = 0; i < 8; ++i) { int slot = slot0 + i; slot = slot >= 9 ? slot - 9 : slot;
                        const LAS unsigned char* vbase = lds + VRING_OFF + slot * 8192;
#pragma unroll
                        for (int hb = 0; hb < 4; ++hb) { const int ch = 2 * hb + (pp >> 1);
                            const s16x4 vlo = __builtin_amdgcn_ds_read_tr16_b64_v4i16((LAS s16x4*)(vbase + tokx * 128 + ((ch ^ swx) * 16) + 8 * (pp & 1)));
                            const s16x4 vhi = __builtin_amdgcn_ds_read_tr16_b64_v4i16((LAS s16x4*)(vbase + toky * 128 + ((ch ^ swy) * 16) + 8 * (pp & 1)));
                            const bf16x8 vf = (bf16x8){vlo[0], vlo[1], vlo[2], vlo[3], vhi[0], vhi[1], vhi[2], vhi[3]};
                            o[hb] = __builtin_amdgcn_mfma_f32_16x16x32_bf16(vf, pf[i], o[hb], 0, 0, 0); } }
                    const float rl = 1.0f / (lsum * SC_KV8);
                    unsigned char* op = mix8 + tq * MIXP + h * 64 + 4 * g4; const float rla = rl * SC_A8;
#pragma unroll
                    for (int hb = 0; hb < 4; ++hb) *(unsigned*)(op + 16 * hb) = pk4_fp8(o[hb][0] * rla, o[hb][1] * rla, o[hb][2] * rla, o[hb][3] * rla);
                    if (do_pool) {
#pragma unroll
                        for (int tt = 0; tt < 2; ++tt) { const int t = ptb0 + 2 * s + tt; const int wlo = (t - phalf) < 0 ? 0 : (t - phalf), whi = (t + phalf) > SEQ ? SEQ : (t + phalf);
                            const float rc = 1.0f / (float)(whi - wlo), ma = (t + phalf < SEQ) ? 1.f : 0.f, ms = (t - phalf >= 0) ? -1.f : 0.f;
                            const u32x4 cw = pl_[tt][0], aw = pl_[tt][1], sw_ = pl_[tt][2];
                            const float cv[8] = {bf_lo(cw.x), bf_hi(cw.x), bf_lo(cw.y), bf_hi(cw.y), bf_lo(cw.z), bf_hi(cw.z), bf_lo(cw.w), bf_hi(cw.w)};
                            const float av[8] = {bf_lo(aw.x), bf_hi(aw.x), bf_lo(aw.y), bf_hi(aw.y), bf_lo(aw.z), bf_hi(aw.z), bf_lo(aw.w), bf_hi(aw.w)};
                            const float sv[8] = {bf_lo(sw_.x), bf_hi(sw_.x), bf_lo(sw_.y), bf_hi(sw_.y), bf_lo(sw_.z), bf_hi(sw_.z), bf_lo(sw_.w), bf_hi(sw_.w)};
                            float o_[8];
#pragma unroll
                            for (int c = 0; c < 8; ++c) { o_[c] = psum[c] * rc - cv[c]; psum[c] += ma * av[c] + ms * sv[c]; }
                            u32x4 w; w.x = cvt_pk_bf16(o_[0], o_[1]); w.y = cvt_pk_bf16(o_[2], o_[3]); w.z = cvt_pk_bf16(o_[4], o_[5]); w.w = cvt_pk_bf16(o_[6], o_[7]);
                            *(u32x4*)(pob + (size_t)t * MIXP) = w; } }
                    __syncthreads();
#pragma unroll
                    for (int j = 0; j < 2; ++j) if (j < nnew) { const int kr = hi_loaded + 1 + j; const int sl = kr % 9; RING_PUT(sl, pk_[j]); }
                    hi_loaded = next_hi;
                    __syncthreads();
                }
            }
            {
                const int half = 1 << (lane >> 4);
                for (int rg = bx * NWAVES + wave + (pooled_inline ? G * NWAVES : 0); rg < T / 32; rg += G * NWAVES) {
                    const int t0 = rg * 32, bb = t0 / SEQ, tb0 = t0 % SEQ;
                    const bf16* ub = proj + (size_t)bb * SEQ * DIN + 1536 + lane * 8;
                    unsigned char* ob = mix8 + (size_t)bb * SEQ * MIXP + 512 + lane * 16;
                    float sum[8];
#pragma unroll
                    for (int c = 0; c < 8; ++c) sum[c] = 0.f;
                    for (int d = -8; d < 8; ++d) { const int j = tb0 + d; if (d >= -half && d < half && j >= 0 && j < SEQ) { const u32x4 w = *(const u32x4*)(ub + (size_t)j * DIN);
                            sum[0] += bf_lo(w.x); sum[1] += bf_hi(w.x); sum[2] += bf_lo(w.y); sum[3] += bf_hi(w.y); sum[4] += bf_lo(w.z); sum[5] += bf_hi(w.z); sum[6] += bf_lo(w.w); sum[7] += bf_hi(w.w); } }
#pragma unroll 4
                    for (int tt = 0; tt < 32; ++tt) { const int t = tb0 + tt; const int wlo = (t - half) < 0 ? 0 : (t - half), whi = (t + half) > SEQ ? SEQ : (t + half);
                        const float rc = 1.0f / (float)(whi - wlo);
                        const u32x4 cw = *(const u32x4*)(ub + (size_t)t * DIN);
                        float o_[8]; const float cv[8] = {bf_lo(cw.x), bf_hi(cw.x), bf_lo(cw.y), bf_hi(cw.y), bf_lo(cw.z), bf_hi(cw.z), bf_lo(cw.w), bf_hi(cw.w)};
#pragma unroll
                        for (int c = 0; c < 8; ++c) o_[c] = sum[c] * rc - cv[c];
                        u32x4 w; w.x = cvt_pk_bf16(o_[0], o_[1]); w.y = cvt_pk_bf16(o_[2], o_[3]); w.z = cvt_pk_bf16(o_[4], o_[5]); w.w = cvt_pk_bf16(o_[6], o_[7]);
                        *(u32x4*)(ob + (size_t)t * MIXP) = w;
                        if (t + half < SEQ) { const u32x4 a = *(const u32x4*)(ub + (size_t)(t + half) * DIN);
                            sum[0] += bf_lo(a.x); sum[1] += bf_hi(a.x); sum[2] += bf_lo(a.y); sum[3] += bf_hi(a.y); sum[4] += bf_lo(a.z); sum[5] += bf_hi(a.z); sum[6] += bf_lo(a.w); sum[7] += bf_hi(a.w); }
                        if (t - half >= 0) { const u32x4 a = *(const u32x4*)(ub + (size_t)(t - half) * DIN);
                            sum[0] -= bf_lo(a.x); sum[1] -= bf_hi(a.x); sum[2] -= bf_lo(a.y); sum[3] -= bf_hi(a.y); sum[4] -= bf_lo(a.z); sum[5] -= bf_hi(a.z); sum[6] -= bf_lo(a.w); sum[7] -= bf_hi(a.w); }
                    }
                }
            }
            __syncthreads();
        }
        SEAM(pb + 1);
        if (IN(pb + 2)) for (int rep_ = 0; rep_ < (l == 0 ? REP_P3L0 : 1); ++rep_) {
        WS_PTRS();
            pg8::Gemm g{MIXP / 2, MIXP / 2, MIXP / 2, 1 << 20, (unsigned)(128 * MIXP), nullptr, 4};
            pg8::StaticOrder S; S.init(mix8, Wout8 + (size_t)l * D * MIXP, MIXP / 2, MIXP / 2, T, D, G, opaque_s(bx), 1);
            pg8::EpiRes E{xb, x8};
            pg8::gemm_phase<pg8::EpiRes, pg8::StaticOrder, false, 2, false, 2>(lds, wave_s, g, S, E);
        }
        SEAM(pb + 2);
        if (IN(pb + 3)) {
        WS_PTRS();
        PHASE_IDS();
            volatile LAS int* cntl = (volatile LAS int*)(MISC + MW_CNTL); volatile LAS int* basel = (volatile LAS int*)(MISC + MW_BASEL);
            { const u32x4* src = rfrag + (size_t)l * 8192; for (int i = tid; i < 8192; i += NTHREADS) ((LAS u32x4*)lds)[i] = src[i]; }
            gu32* gcnt = ctl + CW_CNT + 32 * l;
            for (int it = 0;; ++it) {
                const int tile0 = (it * G + bx) * NWAVES; if (tile0 >= T / 32) break;
                if (tid < NBUCKET) cntl[tid] = 0;
                __syncthreads();
                const int tile = tile0 + wave, tokn = tile * 32 + (lane & 31), kg = lane >> 5;
                const u32x4* xr = (const u32x4*)(xb + (size_t)tokn * D + kg * 32);
                f32x16 acc;
#pragma unroll
                for (int i = 0; i < 16; ++i) acc[i] = 0.f;
                float ss = 0.f;
#pragma unroll 4
                for (int G4 = 0; G4 < 16; ++G4) { u32x4 v[4];
#pragma unroll
                    for (int j = 0; j < 4; ++j) v[j] = xr[G4 * 8 + j];
#pragma unroll
                    for (int s4 = 0; s4 < 4; ++s4) { const u32x4 hw = v[s4];
                        const float f0 = bf_lo(hw.x), f1 = bf_hi(hw.x), f2 = bf_lo(hw.y), f3 = bf_hi(hw.y), f4 = bf_lo(hw.z), f5 = bf_hi(hw.z), f6 = bf_lo(hw.w), f7 = bf_hi(hw.w);
                        ss += ((f0 * f0 + f1 * f1) + (f2 * f2 + f3 * f3)) + ((f4 * f4 + f5 * f5) + (f6 * f6 + f7 * f7));
                        const int step = G4 * 4 + s4;
                        const bf16x8 ah = *(const LAS bf16x8*)(lds + ((0 * 64 + step) * 64 + lane) * 16), al = *(const LAS bf16x8*)(lds + ((1 * 64 + step) * 64 + lane) * 16);
                        const bf16x8 bh_ = __builtin_bit_cast(bf16x8, hw);
                        acc = __builtin_amdgcn_mfma_f32_32x32x16_bf16(ah, bh_, acc, 0, 0, 0);
                        acc = __builtin_amdgcn_mfma_f32_32x32x16_bf16(al, bh_, acc, 0, 0, 0); } }
                ss += __shfl_xor(ss, 32);
                const float rs = __builtin_amdgcn_rsqf(ss * (1.0f / D) + EPS);
                const float g0 = acc[0] * rs, g1 = acc[1] * rs, g2 = acc[2] * rs, g3 = acc[3] * rs;
                int gi = 0; float gb = g0; if (g1 > gb) { gb = g1; gi = 1; } if (g2 > gb) { gb = g2; gi = 2; } if (g3 > gb) { gb = g3; gi = 3; }
                const float gsum = fast_exp2((g0 - gb) * LOG2E) + fast_exp2((g1 - gb) * LOG2E) + fast_exp2((g2 - gb) * LOG2E) + fast_exp2((g3 - gb) * LOG2E);
                const float gwt = 1.0f / gsum;
                const bool hiq = (gi >> 1) != 0;
                const float e0 = (hiq ? acc[8] : acc[4]) * rs, e1 = (hiq ? acc[9] : acc[5]) * rs, e2 = (hiq ? acc[10] : acc[6]) * rs, e3 = (hiq ? acc[11] : acc[7]) * rs;
                int i1 = 0; float v1 = e0; if (e1 > v1) { v1 = e1; i1 = 1; } if (e2 > v1) { v1 = e2; i1 = 2; } if (e3 > v1) { v1 = e3; i1 = 3; }
                int i2 = (i1 == 0) ? 1 : 0; float v2 = (i1 == 0) ? e1 : e0;
                if (i1 != 1 && i2 != 1 && e1 > v2) { v2 = e1; i2 = 1; }
                if (i1 != 2 && e2 > v2) { v2 = e2; i2 = 2; }
                if (i1 != 3 && e3 > v2) { v2 = e3; i2 = 3; }
                const float w1 = gwt / (1.0f + fast_exp2((v2 - v1) * LOG2E)), w2 = gwt - w1;
                const int ea = i1 < i2 ? i1 : i2, eb = i1 < i2 ? i2 : i1; const float wa = i1 < i2 ? w1 : w2, wb = i1 < i2 ? w2 : w1;
                const int bucket = gi * 6 + (ea == 0 ? 0 : (ea == 1 ? 3 : 5)) + (eb - ea - 1);
                const bool owner = (kg == (gi & 1));
                int rank = 0;
                if (owner) rank = __hip_atomic_fetch_add((LAS int*)(MISC + MW_CNTL) + bucket, 1, __ATOMIC_RELAXED, __HIP_MEMORY_SCOPE_WORKGROUP);
                __syncthreads();
                if (tid < NBUCKET) { const int c = cntl[tid]; basel[tid] = c ? (int)__hip_atomic_fetch_add(gcnt + tid, (unsigned)c, RLX_AGENT) : 0; }
                __syncthreads();
                if (owner) { u32x4 e; e.x = (unsigned)tokn; e.y = __float_as_uint(rs * (1.0f / (SC_X8 * SC_WGU))); e.z = __float_as_uint(wa * SC_H8); e.w = __float_as_uint(wb * SC_H8);
                    list[(size_t)bucket * T + basel[bucket] + rank] = e; }
            }
            __syncthreads();
        }
        SEAM(pb + 3);
        if (IN(pb + 4) || IN(pb + 5)) {
        PHASE_IDS();
            volatile LAS int* tb = (volatile LAS int*)(MISC + MW_TB); volatile LAS int* cnt2 = (volatile LAS int*)(MISC + MW_CNT2);
            __syncthreads();
            if (tid == 0) { int a = 0;
#pragma nounroll
                for (int k = 0; k < NBUCKET; ++k) { const int c = (int)__hip_atomic_load(ctl + CW_CNT + 32 * l + k, RLX_AGENT); cnt2[k] = c; tb[k] = a; a += (c + 255) >> 8; } tb[NBUCKET] = a; }
            __syncthreads();
        }
        if (IN(pb + 4)) for (int rep_ = 0; rep_ < REP_P5; ++rep_) {
        WS_PTRS();
            const volatile LAS int* tb = (const volatile LAS int*)(MISC + MW_TB);
            pg8::Gemm g{D / 2, D / 2, D / 2, 1 << 20, (unsigned)(512 * D), nullptr};
            MoeOrder<8> S{tb, (const volatile LAS int*)(MISC + MW_CNT2), tb[NBUCKET] * 8, G, opaque_s(vcu), (const char*)x8, (const char*)(Wgu8 + (size_t)l * NE * 1024 * D), list};
            pg8::EpiSwiglu E{H8};
            pg8::gemm_phase<pg8::EpiSwiglu, MoeOrder<8>, true, 1, false, true>(lds, wave_s, g, S, E);
        }
        SEAM(pb + 4);
        if (IN(pb + 5)) {
        WS_PTRS();
            const volatile LAS int* tb = (const volatile LAS int*)(MISC + MW_TB);
            pg8::Gemm g{D / 2, DE / 2, D / 2, 4, (unsigned)(128 * DE), nullptr};
            MoeOrder<4> S{tb, (const volatile LAS int*)(MISC + MW_CNT2), tb[NBUCKET] * 4, G, opaque_s(vcu), (const char*)H8, (const char*)(Wd8 + (size_t)l * NE * 1024 * DE), list};
            pg8::EpiScatter E{xb, ssq, x8};
            pg8::gemm_phase<pg8::EpiScatter, MoeOrder<4>, true, 2, true, true>(lds, wave_s, g, S, E);
            if (l + 1 < DEPTH) {
                const int rem = S.nunits % G; const bool slack = rem != 0 && S.c >= rem;
                if (rem == 0 || slack) { PHASE_IDS(); LAS float* scr = (LAS float*)(lds + wave * 16384);
                    const int gwx = (rem == 0 ? S.c : S.c - rem) * NWAVES + wave, ngwx = (rem == 0 ? G : G - rem) * NWAVES;
                    CONVERT_WEIGHTS(l + 1, l + 2, gwx, ngwx) } }
        }
        SEAM(pb + 5);
    }
    if (IN(N_PHASES - 1)) {
        PHASE_IDS();
        WS_PTRS();
        const f32x4* gp8 = (const f32x4*)final_g;
        for (int m0 = gw * 4; m0 < T; m0 += NGW * 4) {
            u32x4 v[4][2];
#pragma unroll
            for (int rr = 0; rr < 4; ++rr)
#pragma unroll
                for (int j = 0; j < 2; ++j) v[rr][j] = ((const u32x4*)(xb + (size_t)(m0 + rr) * D))[lane + 64 * j];
#pragma unroll
            for (int rr = 0; rr < 4; ++rr) { float f[2][8]; float s = 0.f;
#pragma unroll
                for (int j = 0; j < 2; ++j) { const u32x4 w = v[rr][j]; f[j][0] = bf_lo(w.x); f[j][1] = bf_hi(w.x); f[j][2] = bf_lo(w.y); f[j][3] = bf_hi(w.y); f[j][4] = bf_lo(w.z); f[j][5] = bf_hi(w.z); f[j][6] = bf_lo(w.w); f[j][7] = bf_hi(w.w);
#pragma unroll
                    for (int c = 0; c < 8; ++c) s += f[j][c] * f[j][c]; }
                s = wave_sum(s); const float rs = 1.0f / sqrtf(s * (1.0f / D) + EPS);
                float* orow = args.out + (size_t)(m0 + rr) * D;
#pragma unroll
                for (int j = 0; j < 2; ++j) { const f32x4 ga = gp8[(lane + 64 * j) * 2], gb = gp8[(lane + 64 * j) * 2 + 1];
                    *(f32x4*)(orow + 8 * (lane + 64 * j)) = (f32x4){f[j][0], f[j][1], f[j][2], f[j][3]} * rs * ga;
                    *(f32x4*)(orow + 8 * (lane + 64 * j) + 4) = (f32x4){f[j][4], f[j][5], f[j][6], f[j][7]} * rs * gb; } }
        }
    }
#undef IN
#undef SEAM
#undef PHASE_IDS
#undef RING_PUT
#undef WS_PTRS
}

extern "C" void kernel_launch(void* const* d_in, const int* in_sizes, int n_in, void* d_out, int out_size, void* d_ws, size_t ws_size, hipStream_t stream) {
    static int grid = 0;
    if (grid == 0) {
        if (n_in != 14 || in_sizes[0] != T * D || out_size != T * D || ws_size < WS_END) { fprintf(stderr, "kernel_launch: unexpected shapes / workspace (n_in %d, ws %zu)\n", n_in, ws_size); grid = -1; return; }
        int dev = 0, cus = 0, per_cu = 0;
        if (hipGetDevice(&dev) != hipSuccess || hipDeviceGetAttribute(&cus, hipDeviceAttributeMultiprocessorCount, dev) != hipSuccess) { grid = -1; return; }
        if (hipFuncSetAttribute((const void*)enc_fwd, hipFuncAttributeMaxDynamicSharedMemorySize, LDS_BYTES) != hipSuccess) { fprintf(stderr, "kernel_launch: hipFuncSetAttribute failed\n"); grid = -1; return; }
        if (hipOccupancyMaxActiveBlocksPerMultiprocessor(&per_cu, (const void*)enc_fwd, NTHREADS, LDS_BYTES) != hipSuccess || per_cu < 1) { fprintf(stderr, "kernel_launch: occupancy query reports %d\n", per_cu); }
        (void)hipGetLastError();
        grid = cus;
    }
    if (grid < 0) return;
    (void)hipMemsetAsync((char*)d_ws + WS_CTL, 0, CTL_ZERO_BYTES, stream);
    Args a{};
    for (int i = 0; i < 14; ++i) a.in[i] = (const float*)d_in[i];
    a.out = (float*)d_out; a.ws = (unsigned char*)d_ws; a.pad = 0;
    if (MK_N_LAUNCHES == 1) {
        a.ph_lo = 0; a.ph_hi = N_PHASES; a.li = 0;
        hipLaunchKernelGGL(enc_fwd, dim3(grid), dim3(NTHREADS), LDS_BYTES, stream, a);
    } else {
        for (int p = 0; p < N_PHASES; ++p) { a.ph_lo = p; a.ph_hi = p + 1; a.li = p; hipLaunchKernelGGL(enc_fwd, dim3(grid), dim3(NTHREADS), LDS_BYTES, stream, a); }
    }
}
```
